# Optimizing an MI355X kernel written in HIP

```python
import jax, jax.numpy as jnp
from jax import lax
import numpy as np

D_MODEL = 2048
BATCH = 1
SEQ = 8192
DEPTH = 4

CHUNK = 64
N_META = 16
Q_BLOCK = 128
MLA_HEADS = 8
MLA_Q_LORA = 512
MLA_KV_LORA = 512
MLA_NOPE = 128
MLA_ROPE = 64
MLA_V = 128
ROPE_THETA = 10000.0
FOX_HEADS = 8
FOX_HD = 128
FOX_W = FOX_HEADS * FOX_HD
FORGET_BIAS = 3.0
MIX_WIDTH = MLA_HEADS * MLA_V + FOX_W
D_FF = 5632
CONV_K = 3
EPS = 1e-6
NEG = -1e30
IN_SPLIT_SIZES = (MLA_Q_LORA, MLA_KV_LORA, MLA_ROPE, FOX_W, FOX_W, FOX_W, FOX_W, FOX_HEADS)
IN_COLS = sum(IN_SPLIT_SIZES)

kernel_name = "hybrid_mla_fox_convffn_trunk"


def rms_norm(x, g):
    xf = x.astype(jnp.float32)
    y = xf * lax.rsqrt(jnp.mean(xf * xf, axis=-1, keepdims=True) + EPS)
    return (y * g.astype(jnp.float32)).astype(x.dtype)


def apply_rope(x, cos, sin):
    xf = x.astype(jnp.float32)
    half = xf.shape[-1] // 2
    x1, x2 = xf[..., :half], xf[..., half:]
    out = jnp.concatenate([x1 * cos - x2 * sin, x2 * cos + x1 * sin], axis=-1)
    return out.astype(x.dtype)


def mla_mixer(c_q, c_kv, k_rope, g_q, g_kv, w_q_up, w_kv_up, cos, sin, chunk_id):
    B, L, _ = c_q.shape
    q = (rms_norm(c_q, g_q) @ w_q_up).reshape(B, L, MLA_HEADS, MLA_NOPE + MLA_ROPE)
    q_nope = q[..., :MLA_NOPE]
    q_rope = apply_rope(q[..., MLA_NOPE:], cos[None, :, None], sin[None, :, None])
    kv = (rms_norm(c_kv, g_kv) @ w_kv_up).reshape(B, L, MLA_HEADS, MLA_NOPE + MLA_V)
    k_nope, v = kv[..., :MLA_NOPE], kv[..., MLA_NOPE:]
    k_r = apply_rope(k_rope, cos[None], sin[None])
    scale = (MLA_NOPE + MLA_ROPE) ** -0.5

    def one_block(start):
        qn = lax.dynamic_slice_in_dim(q_nope, start, Q_BLOCK, axis=1)
        qr = lax.dynamic_slice_in_dim(q_rope, start, Q_BLOCK, axis=1)
        cq = lax.dynamic_slice_in_dim(chunk_id, start, Q_BLOCK)
        s = (jnp.einsum('bqhd,bkhd->bhqk', qn, k_nope)
             + jnp.einsum('bqhr,bkr->bhqk', qr, k_r)).astype(jnp.float32) * scale
        mask = chunk_id[None, :] <= cq[:, None]
        s = jnp.where(mask, s, NEG)
        p = jax.nn.softmax(s, axis=-1).astype(v.dtype)
        return jnp.einsum('bhqk,bkhd->bqhd', p, v)

    starts = jnp.arange(L // Q_BLOCK, dtype=jnp.int32) * Q_BLOCK
    out = lax.map(one_block, starts)
    return jnp.moveaxis(out, 0, 1).reshape(B, L, MLA_HEADS * MLA_V)


def fox_mixer(q, k, v, gate, f_logit, b_f, g_q, g_k, pos):
    B, L, _ = q.shape
    q = rms_norm(q.reshape(B, L, FOX_HEADS, FOX_HD), g_q)
    k = rms_norm(k.reshape(B, L, FOX_HEADS, FOX_HD), g_k)
    v = v.reshape(B, L, FOX_HEADS, FOX_HD)
    log_f = jax.nn.log_sigmoid(f_logit.astype(jnp.float32) + b_f.astype(jnp.float32))
    c = jnp.cumsum(log_f, axis=1).transpose(0, 2, 1)
    scale = FOX_HD ** -0.5

    def one_block(start):
        qb = lax.dynamic_slice_in_dim(q, start, Q_BLOCK, axis=1)
        cq = lax.dynamic_slice_in_dim(c, start, Q_BLOCK, axis=2)
        pq = lax.dynamic_slice_in_dim(pos, start, Q_BLOCK)
        s = jnp.einsum('bqhd,bkhd->bhqk', qb, k).astype(jnp.float32) * scale
        s = s + cq[..., :, None] - c[..., None, :]
        mask = pos[None, :] <= pq[:, None]
        s = jnp.where(mask, s, NEG)
        p = jax.nn.softmax(s, axis=-1).astype(v.dtype)
        return jnp.einsum('bhqk,bkhd->bqhd', p, v)

    starts = jnp.arange(L // Q_BLOCK, dtype=jnp.int32) * Q_BLOCK
    out = jnp.moveaxis(lax.map(one_block, starts), 0, 1).reshape(B, L, FOX_W)
    return out * jax.nn.sigmoid(gate)


def conv_ffn(x, w_up, w_conv, b_conv, w_down):
    L = x.shape[1]
    h = x @ w_up
    hp = jnp.pad(h, ((0, 0), (CONV_K - 1, 0), (0, 0)))
    h = b_conv + sum(w_conv[j] * hp[:, j:j + L] for j in range(CONV_K))
    gate, up = jnp.split(h, 2, axis=-1)
    return (jax.nn.gelu(gate, approximate=True) * up) @ w_down


def setup_inputs(seed: int = 0) -> dict:
    key = jax.random.key(seed)
    ks = jax.random.split(key, 20)
    f32 = jnp.float32
    nrm = lambda k, shp, s: jax.random.normal(k, shp, f32) * s
    gain = lambda k, shp: 1.0 + 0.05 * jax.random.normal(k, shp, f32)
    return {
        "x": jax.random.normal(ks[0], (BATCH, SEQ, D_MODEL), f32),
        "meta_tokens": nrm(ks[1], (N_META, D_MODEL), 1.0),
        "ln_mix_pre": gain(ks[2], (DEPTH, D_MODEL)),
        "w_in": nrm(ks[3], (DEPTH, D_MODEL, IN_COLS), D_MODEL ** -0.5),
        "b_forget": FORGET_BIAS + 0.5 * jax.random.normal(ks[4], (DEPTH, FOX_HEADS), f32),
        "g_q_latent": gain(ks[5], (DEPTH, MLA_Q_LORA)),
        "g_kv_latent": gain(ks[6], (DEPTH, MLA_KV_LORA)),
        "w_q_up": nrm(ks[7], (DEPTH, MLA_Q_LORA, MLA_HEADS * (MLA_NOPE + MLA_ROPE)), MLA_Q_LORA ** -0.5),
        "w_kv_up": nrm(ks[8], (DEPTH, MLA_KV_LORA, MLA_HEADS * (MLA_NOPE + MLA_V)), MLA_KV_LORA ** -0.5),
        "g_fox_q": gain(ks[9], (DEPTH, FOX_HD)),
        "g_fox_k": gain(ks[10], (DEPTH, FOX_HD)),
        "w_out": nrm(ks[11], (DEPTH, MIX_WIDTH, D_MODEL), MIX_WIDTH ** -0.5),
        "ln_mix_post": gain(ks[12], (DEPTH, D_MODEL)),
        "ln_ffn_pre": gain(ks[13], (DEPTH, D_MODEL)),
        "w_ffn_up": nrm(ks[14], (DEPTH, D_MODEL, 2 * D_FF), D_MODEL ** -0.5),
        "w_ffn_conv": nrm(ks[15], (DEPTH, CONV_K, 2 * D_FF), CONV_K ** -0.5),
        "b_ffn_conv": nrm(ks[16], (DEPTH, 2 * D_FF), 0.02),
        "w_ffn_down": nrm(ks[17], (DEPTH, D_FF, D_MODEL), D_FF ** -0.5),
        "ln_ffn_post": gain(ks[18], (DEPTH, D_MODEL)),
    }


def reference(x, meta_tokens, ln_mix_pre, w_in, b_forget, g_q_latent, g_kv_latent, w_q_up, w_kv_up,
              g_fox_q, g_fox_k, w_out, ln_mix_post, ln_ffn_pre, w_ffn_up, w_ffn_conv, b_ffn_conv,
              w_ffn_down, ln_ffn_post):
    B, S, D = x.shape
    L = N_META + S
    L_pad = -(-L // Q_BLOCK) * Q_BLOCK
    h = jnp.concatenate([
        jnp.broadcast_to(meta_tokens.astype(x.dtype)[None], (B, N_META, D)),
        x,
        jnp.zeros((B, L_pad - L, D), x.dtype)], axis=1)
    pos = jnp.arange(L_pad, dtype=jnp.int32)
    chunk_id = jnp.where(pos < N_META, 0,
                         jnp.where(pos < L, 1 + (pos - N_META) // CHUNK, 2 + S // CHUNK)).astype(jnp.int32)
    half = MLA_ROPE // 2
    inv_freq = ROPE_THETA ** (-jnp.arange(half, dtype=jnp.float32) / half)
    ang = pos.astype(jnp.float32)[:, None] * inv_freq[None, :]
    cos, sin = jnp.cos(ang), jnp.sin(ang)
    split_idx = [int(v) for v in np.cumsum(IN_SPLIT_SIZES)[:-1]]

    for l in range(DEPTH):
        hn = rms_norm(h, ln_mix_pre[l])
        c_q, c_kv, k_rope, fq, fk, fv, fg, ff = jnp.split(hn @ w_in[l], split_idx, axis=-1)
        a = mla_mixer(c_q, c_kv, k_rope, g_q_latent[l], g_kv_latent[l], w_q_up[l], w_kv_up[l],
                      cos, sin, chunk_id)
        b = fox_mixer(fq, fk, fv, fg, ff, b_forget[l], g_fox_q[l], g_fox_k[l], pos)
        mix = jnp.concatenate([a, b], axis=-1) @ w_out[l]
        h = h + rms_norm(mix, ln_mix_post[l])
        f = conv_ffn(rms_norm(h, ln_ffn_pre[l]), w_ffn_up[l], w_ffn_conv[l], b_ffn_conv[l], w_ffn_down[l])
        h = h + rms_norm(f, ln_ffn_post[l])

    return h[:, N_META:N_META + S]
```

```cpp
#include <hip/hip_runtime.h>
#include <hip/hip_cooperative_groups.h>
#include <cstdio>
#include <cstdint>
namespace cg = cooperative_groups;

#ifndef SINGLE_LAUNCH
#define SINGLE_LAUNCH 1
#endif

#define LAS __attribute__((address_space(3)))
typedef unsigned short bf16_t;
typedef short bf16x8 __attribute__((ext_vector_type(8)));
typedef short s16x4 __attribute__((ext_vector_type(4)));
typedef float f32x4 __attribute__((ext_vector_type(4)));
typedef float f32x16 __attribute__((ext_vector_type(16)));
typedef unsigned u32x4 __attribute__((ext_vector_type(4)));
typedef unsigned u32x2 __attribute__((ext_vector_type(2)));

constexpr int MROWS = 8448;
constexpr int PADR = 240, FRAME0 = 256, NMETA = 16, DM = 2048, NLAYER = 4;
constexpr int INC = 5192;
constexpr int ZLD = 5376;
constexpr int DFF = 5632, DFF2 = 11264;
constexpr float EPSN = 1e-6f, LOG2E = 1.4426950408889634f;
constexpr float QS_MLA = 0.07216878364870322f * LOG2E;
constexpr float QS_FOX = 0.08838834764831845f * LOG2E;
constexpr int NTHREADS = 512;
constexpr int LDS_BYTES = 131072;
constexpr int LDS_TOTAL = LDS_BYTES + 256;

constexpr size_t WL_IN = 0;
constexpr size_t WL_QUP = WL_IN + (size_t)ZLD * DM * 2;
constexpr size_t WL_KVUP = WL_QUP + (size_t)1536 * 512 * 2;
constexpr size_t WL_OUT = WL_KVUP + (size_t)2048 * 512 * 2;
constexpr size_t WL_UP = WL_OUT + (size_t)2048 * 2048 * 2;
constexpr size_t WL_DOWN = WL_UP + (size_t)DFF2 * DM * 2;
constexpr size_t WL_SIZE = WL_DOWN + (size_t)DM * DFF * 2;
constexpr size_t WS_W = 0;
constexpr size_t WS_H = WS_W + NLAYER * WL_SIZE;
constexpr size_t WS_ABF = WS_H + (size_t)MROWS * DM * 4;
constexpr size_t WS_Z = WS_ABF + (size_t)MROWS * DM * 2;
constexpr size_t WS_QM = WS_Z + (size_t)MROWS * ZLD * 2;
constexpr size_t WS_KV = WS_QM + (size_t)MROWS * 1536 * 2;
constexpr size_t WS_KR = WS_KV + (size_t)MROWS * 2048 * 2;
constexpr size_t WS_QF = WS_KR + (size_t)MROWS * 64 * 2;
constexpr size_t WS_KF = WS_QF + (size_t)MROWS * 1024 * 2;
constexpr size_t WS_CAT = WS_KF + (size_t)MROWS * 1024 * 2;
constexpr size_t WS_MIX = WS_CAT + (size_t)MROWS * DM * 2;
constexpr size_t WS_U = WS_MIX + (size_t)MROWS * DM * 4;
constexpr size_t WS_G = WS_U + (size_t)MROWS * DFF2 * 2;
constexpr size_t WS_SSQH = WS_G + (size_t)MROWS * DFF * 2;
constexpr size_t WS_SSQC = WS_SSQH + (size_t)MROWS * 4;
constexpr size_t WS_LF = WS_SSQC + (size_t)MROWS * 16 * 4;
constexpr size_t WS_BK = WS_LF + (size_t)MROWS * 8 * 4;
constexpr size_t WS_COS = WS_BK + (size_t)MROWS * 8 * 4;
constexpr size_t WS_SIN = WS_COS + (size_t)MROWS * 32 * 4;
constexpr size_t WS_CTR = WS_SIN + (size_t)MROWS * 32 * 4;
constexpr size_t WS_PART = WS_CTR + 256;
constexpr size_t WS_PTRS = WS_PART + (size_t)32 * 16 * DM * 4;
constexpr size_t WS_BAR = WS_PTRS + 256;
constexpr size_t WS_END = WS_BAR + 16384;

struct Params {
    const float* in[19];
    float* out;
    unsigned char* ws;
    int ph_lo, ph_hi;
};
enum { I_X = 0, I_META, I_LNMIXPRE, I_WIN, I_BF, I_GQL, I_GKVL, I_WQUP, I_WKVUP, I_GFQ, I_GFK, I_WOUT, I_LNMIXPOST, I_LNFFNPRE, I_WUP, I_WCONV, I_BCONV, I_WDOWN, I_LNFFNPOST };

__device__ __forceinline__ unsigned cvt_pk_bf16(float lo, float hi) { unsigned r; asm volatile("v_cvt_pk_bf16_f32 %0, %1, %2" : "=v"(r) : "v"(lo), "v"(hi)); return r; }
__device__ __forceinline__ float bf_lo(unsigned w) { return __uint_as_float(w << 16); }
__device__ __forceinline__ float bf_hi(unsigned w) { return __uint_as_float(w & 0xffff0000u); }
__device__ __forceinline__ void unpack8(const u32x4 w, float* v) {
    v[0] = bf_lo(w.x); v[1] = bf_hi(w.x); v[2] = bf_lo(w.y); v[3] = bf_hi(w.y); v[4] = bf_lo(w.z); v[5] = bf_hi(w.z); v[6] = bf_lo(w.w); v[7] = bf_hi(w.w);
}
__device__ __forceinline__ int opaque_tid() { int t = threadIdx.x; asm volatile("" : "+v"(t)); return t; }
__device__ __forceinline__ float wave_sum(float v) {
#pragma unroll
    for (int o = 32; o >= 1; o >>= 1) v += __shfl_xor(v, o);
    return v;
}


#define XB_TMO      128
#define XB_XCNT(j)  (256  + 64 * (j))
#define XB_XSUB(j)  (1280 + 64 * (j))
#define XB_XGEN(j)  (2304 + 64 * (j))
#define XB_TOP      3328
#define XB_TOPGEN   3392
#define XCD_BAR_WORDS 3456
#define XB_SPIN_CAP (1u << 18)
__device__ __forceinline__ unsigned xb_ld(unsigned* p)              { return __hip_atomic_load(p, __ATOMIC_RELAXED, __HIP_MEMORY_SCOPE_AGENT); }
__device__ __forceinline__ unsigned xb_add(unsigned* p, unsigned v) { return __hip_atomic_fetch_add(p, v, __ATOMIC_RELAXED, __HIP_MEMORY_SCOPE_AGENT); }
__device__ __forceinline__ unsigned xb_xcc_id() { return (unsigned)__builtin_amdgcn_s_getreg((3 << 11) | 20) & 0xFu; }
#define XB_SPIN(cond, bar) do { unsigned _sp = 0; while (cond) { __builtin_amdgcn_s_sleep(1); \
    if ((++_sp & 255u) == 0u) { if (xb_ld(&(bar)[XB_TMO])) break; if (_sp > XB_SPIN_CAP) { atomicAdd(&(bar)[XB_TMO], 1u); break; } } } } while (0)
struct XcdBarrier { unsigned* bar; unsigned x; volatile LAS unsigned* st; };
__device__ __forceinline__ XcdBarrier xcd_barrier_post(unsigned* bar, volatile LAS unsigned* st) {
    XcdBarrier b; b.bar = bar; b.x = xb_xcc_id(); b.st = st;
    if (threadIdx.x == 0) (void)xb_add(&bar[XB_XCNT(b.x)], 1u);
    return b;
}
__device__ __forceinline__ void xcd_barrier_complete(unsigned* bar, unsigned x, unsigned& nloc, unsigned& nx) {
    const unsigned G = gridDim.x * gridDim.y * gridDim.z;
    unsigned sum, cnt, mine, sp = 0u;
    for (;;) {
        sum = 0u; cnt = 0u; mine = 0u;
#pragma unroll
        for (unsigned j = 0; j < 16; ++j) { const unsigned c = xb_ld(&bar[XB_XCNT(j)]); sum += c; cnt += (c > 0u) ? 1u : 0u; mine = (j == x) ? c : mine; }
        if (sum == G) break;
        __builtin_amdgcn_s_sleep(1);
        if ((++sp & 255u) == 0u) { if (xb_ld(&bar[XB_TMO])) break; if (sp > XB_SPIN_CAP) { atomicAdd(&bar[XB_TMO], 1u); break; } }
    }
    nloc = mine > 0u ? mine : 1u; nx = cnt > 0u ? cnt : 1u;
}
__device__ __forceinline__ void xcd_barrier(const XcdBarrier& b) {
    asm volatile("s_waitcnt vmcnt(0)" ::: "memory");
    __syncthreads();
    if (threadIdx.x == 0) {
        unsigned* bar = b.bar;
        __builtin_amdgcn_s_waitcnt(0);
        unsigned nloc = b.st[0], nx = b.st[1];
        if (nloc == 0u) { xcd_barrier_complete(bar, b.x, nloc, nx); b.st[0] = nloc; b.st[1] = nx; }
        const unsigned old = xb_add(&bar[XB_XSUB(b.x)], 1u);
        const unsigned gen = old / nloc;
        if (old + 1u == (gen + 1u) * nloc) {
            __builtin_amdgcn_fence(__ATOMIC_RELEASE, "agent");
            asm volatile("s_waitcnt vmcnt(0)" ::: "memory");
            const unsigned og = xb_add(&bar[XB_TOP], 1u);
            const unsigned tg = og / nx;
            if (og + 1u == (tg + 1u) * nx) xb_add(&bar[XB_TOPGEN], 1u);
            else XB_SPIN(xb_ld(&bar[XB_TOPGEN]) == tg, bar);
            __builtin_amdgcn_fence(__ATOMIC_ACQUIRE, "agent");
            xb_add(&bar[XB_XGEN(b.x)], 1u);
            asm volatile("s_waitcnt vmcnt(0)" ::: "memory");
        } else {
            XB_SPIN(xb_ld(&bar[XB_XGEN(b.x)]) == gen, bar);
            __builtin_amdgcn_fence(__ATOMIC_ACQUIRE, "agent");
            asm volatile("s_waitcnt vmcnt(0)" ::: "memory");
        }
    }
    __syncthreads();
}

namespace pg8 {
constexpr int BM = 256, BK = 64, HALF = 128, HTB = HALF * BK * 2, STAGE_BYTES = 8 * HTB, NXCD = 8, WGM = 8;
__device__ __forceinline__ int lds_byte(int r, int c) { const int st = (r >> 4) * 2 + (c >> 5), rr = r & 15, cc = c & 31, ob = rr * 64 + cc * 2; return st * 1024 + (ob ^ (((ob >> 9) & 1) << 5)); }
__device__ __forceinline__ void stage_rc(int b, int& R, int& C) { const int st = b / 1024, sb = b % 1024, swz = sb ^ (((sb >> 9) & 1) << 5); R = (st >> 1) * 16 + swz / 64; C = (st & 1) * 32 + (swz % 64) / 2; }
__device__ __forceinline__ int perm32(int rho) { const int n = rho >> 4, i = rho & 15; return 8 * (i >> 2) + 4 * n + (i & 3); }
struct Unit { int pm, pn, k0t, nt, part; };
struct Gemm { const char* A; const char* Bt; int lda; int K; int nM, nN; int split; int a_off2; };
struct StaticOrder {
    int nM, nN, nwg, G, c, ntk;
    __device__ void init(int nM_, int nN_, int G_, int c_, int ntk_) { nM = nM_; nN = nN_; nwg = nM * nN; G = G_; c = c_; ntk = ntk_; }
    __device__ bool next(int i, Unit& u) const {
        const long L = (long)i * G + c; if (L >= nwg) return false;
        int wgid = (int)L; { const int q = nwg / NXCD, r = nwg % NXCD, xcd = wgid % NXCD, off = wgid / NXCD; wgid = (xcd < r ? xcd * (q + 1) : r * (q + 1) + (xcd - r) * q) + off; }
        const int nig = WGM * nN, gid = wgid / nig, fm = gid * WGM, gsz = (nM - fm) < WGM ? (nM - fm) : WGM;
        u.pm = fm + ((wgid % nig) % gsz); u.pn = (wgid % nig) / gsz; u.k0t = 0; u.nt = ntk; u.part = -1; return true;
    }
};
struct SplitOrder {
    StaticOrder so; int S, ntp;
    __device__ void init(int nM_, int nN_, int G_, int c_, int ntk_, int S_, int ntp_) { so.init(nM_, nN_, G_, c_, ntk_); S = S_; ntp = ntp_; }
    __device__ bool next(int i, Unit& u) const {
        if (so.next(i, u)) { u.pm += 1; return true; }
        const long L = (long)i * so.G + so.c - so.nwg; if (L >= (long)so.nN * S) return false;
        u.pm = 0; u.pn = (int)(L % so.nN); u.part = (int)(L / so.nN); u.k0t = u.part * ntp; u.nt = ntp; return true;
    }
};

template <class Epi, class Sched>
__device__ __forceinline__ void gemm_phase(LAS unsigned char* lds, const Gemm g, const Sched& S, const Epi& E) {
    const int tid = opaque_tid(), wid = __builtin_amdgcn_readfirstlane(tid >> 6), lane = tid & 63, wr = wid >> 2, wc = wid & 3, fr = lane & 15, fq = lane >> 4;
    const int K = g.K, lda = g.lda;
    unsigned voffA[2], voffB[2];
#pragma unroll
    for (int i = 0; i < 2; ++i) { int R, C; stage_rc(tid * 16 + i * 8192, R, C); const int Rb = Epi::PERM ? ((R & ~31) + perm32(R & 31)) : R;
        voffA[i] = (unsigned)(R * lda + C) * 2u; voffB[i] = (unsigned)(Rb * K + C) * 2u; }
    const size_t kstep = (size_t)(BK * 2);
    const size_t hstepA = (size_t)HALF * lda * 2, hstepB = (size_t)HALF * K * 2;
    const size_t tstepA = 2 * hstepA, tstepB = 2 * hstepB;
    const unsigned ldsw = (unsigned)wid * 1024u;
    const int aoff = lds_byte(wr * 64 + fr, fq * 8), boff = lds_byte(wc * 32 + fr, fq * 8);
#define PG8_SA(b, h) (((b) * 2 + (h)) * HTB)
#define PG8_SB(b, h) ((4 + (b) * 2 + (h)) * HTB)
#define PG8_STAGE(bufoff, gbase, voff) do { _Pragma("unroll") for (int _i = 0; _i < 2; ++_i) \
        __builtin_amdgcn_global_load_lds((const unsigned*)((const char*)(gbase) + (voff)[_i]), (LAS unsigned*)(lds + (bufoff) + ldsw + _i * 8192), 16, 0, 0); } while (0)
#define PG8_LDA(dst, b, h) do { _Pragma("unroll") for (int m = 0; m < 4; ++m) _Pragma("unroll") for (int k = 0; k < 2; ++k) dst[m][k] = *(const LAS bf16x8*)(lds + PG8_SA(b, h) + aoff + m * 2048 + k * 1024); } while (0)
#define PG8_LDB(dst, b, h) do { _Pragma("unroll") for (int n = 0; n < 2; ++n) _Pragma("unroll") for (int k = 0; k < 2; ++k) dst[n][k] = *(const LAS bf16x8*)(lds + PG8_SB(b, h) + boff + n * 2048 + k * 1024); } while (0)
#define PG8_MMA(ai, bj, At, Bt) do { __builtin_amdgcn_s_setprio(1); _Pragma("unroll") for (int m = 0; m < 4; ++m) _Pragma("unroll") for (int n = 0; n < 2; ++n) _Pragma("unroll") for (int k = 0; k < 2; ++k) \
        acc[ai][bj][m][n] = __builtin_amdgcn_mfma_f32_16x16x32_bf16(Bt[n][k], At[m][k], acc[ai][bj][m][n], 0, 0, 0); __builtin_amdgcn_s_setprio(0); } while (0)
#define PG8_WAIT_V(n) asm volatile("s_waitcnt vmcnt(" #n ")" ::: "memory")
#define PG8_WAIT_L(n) asm volatile("s_waitcnt lgkmcnt(" #n ")" ::: "memory")
#define PG8_BAR __builtin_amdgcn_s_barrier()
#define PG8_SCHED __builtin_amdgcn_sched_barrier(0)
#define PG8_APTR(u) (g.A + (size_t)(u).pm * tstepA + ((u).pn >= g.split ? (size_t)g.a_off2 : (size_t)0) + (size_t)(u).k0t * kstep)
#define PG8_BPTR(u) (g.Bt + (size_t)(u).pn * tstepB + (size_t)(u).k0t * kstep)
    Unit cur, nxt; int ui = 0;
    if (!S.next(0, cur)) return;
    f32x4 acc[2][2][4][2];
#pragma unroll
    for (int a = 0; a < 2; ++a)
#pragma unroll
        for (int b = 0; b < 2; ++b)
#pragma unroll
            for (int m = 0; m < 4; ++m)
#pragma unroll
                for (int n = 0; n < 2; ++n) acc[a][b][m][n] = (f32x4){0.f, 0.f, 0.f, 0.f};
    bf16x8 At[4][2], B0[2][2], B1[2][2];
    const char* cA = PG8_APTR(cur); const char* cB = PG8_BPTR(cur);
    PG8_STAGE(PG8_SB(0, 0), cB, voffB); PG8_STAGE(PG8_SA(0, 0), cA, voffA); PG8_STAGE(PG8_SB(0, 1), cB + hstepB, voffB); PG8_STAGE(PG8_SA(0, 1), cA + hstepA, voffA);
    if (wr == 1) PG8_BAR;
    PG8_WAIT_V(4); PG8_BAR;
    PG8_STAGE(PG8_SB(1, 0), cB + kstep, voffB); PG8_STAGE(PG8_SA(1, 0), cA + kstep, voffA); PG8_STAGE(PG8_SB(1, 1), cB + hstepB + kstep, voffB);
    PG8_WAIT_V(6); PG8_BAR;
    for (;;) {
        const bool has_next = S.next(ui + 1, nxt);
        const char* nA = has_next ? PG8_APTR(nxt) : cA; const char* nB = has_next ? PG8_BPTR(nxt) : cB;
        const int nt = cur.nt;
        for (int t = 0; t < nt; t += 2) {
            const bool last = (t == nt - 2);
            const char* a1 = cA + (size_t)(t + 1) * kstep;
            const char* a2 = last ? nA : cA + (size_t)(t + 2) * kstep; const char* b2 = last ? nB : cB + (size_t)(t + 2) * kstep;
            const char* a3 = a2 + kstep; const char* b3 = b2 + kstep;
            PG8_LDB(B0, 0, 0); PG8_SCHED; PG8_LDA(At, 0, 0); PG8_STAGE(PG8_SA(1, 1), a1 + hstepA, voffA);
            PG8_WAIT_L(8); PG8_BAR; PG8_WAIT_L(0); PG8_MMA(0, 0, At, B0); PG8_BAR; PG8_SCHED;
            PG8_LDB(B1, 0, 1); PG8_STAGE(PG8_SB(0, 0), b2, voffB);
            PG8_BAR; PG8_WAIT_L(0); PG8_MMA(0, 1, At, B1); PG8_BAR;
            PG8_LDA(At, 0, 1); PG8_STAGE(PG8_SA(0, 0), a2, voffA);
            PG8_BAR; PG8_WAIT_L(0); PG8_MMA(1, 0, At, B0); PG8_BAR; PG8_SCHED;
            PG8_STAGE(PG8_SB(0, 1), b2 + hstepB, voffB);
            PG8_WAIT_V(6); PG8_BAR; PG8_MMA(1, 1, At, B1); PG8_BAR;
            PG8_LDB(B0, 1, 0); PG8_SCHED; PG8_LDA(At, 1, 0); PG8_STAGE(PG8_SA(0, 1), a2 + hstepA, voffA);
            PG8_WAIT_L(8); PG8_BAR; PG8_WAIT_L(0); PG8_MMA(0, 0, At, B0); PG8_BAR; PG8_SCHED;
            PG8_LDB(B1, 1, 1); PG8_STAGE(PG8_SB(1, 0), b3, voffB);
            PG8_BAR; PG8_WAIT_L(0); PG8_MMA(0, 1, At, B1); PG8_BAR;
            PG8_LDA(At, 1, 1); PG8_STAGE(PG8_SA(1, 0), a3, voffA);
            PG8_BAR; PG8_WAIT_L(0); PG8_MMA(1, 0, At, B0); PG8_BAR; PG8_SCHED;
            PG8_STAGE(PG8_SB(1, 1), b3 + hstepB, voffB);
            PG8_WAIT_V(6); PG8_BAR; PG8_MMA(1, 1, At, B1); PG8_BAR;
        }
        E(acc, cur, wr, wc, fr, fq);
        if (!has_next) break;
#pragma unroll
        for (int a = 0; a < 2; ++a)
#pragma unroll
            for (int b = 0; b < 2; ++b)
#pragma unroll
                for (int m = 0; m < 4; ++m)
#pragma unroll
                    for (int n = 0; n < 2; ++n) acc[a][b][m][n] = (f32x4){0.f, 0.f, 0.f, 0.f};
        cur = nxt; cA = nA; cB = nB; ++ui;
    }
    PG8_WAIT_V(0);
    if (wr == 0) PG8_BAR;
    PG8_BAR;
#undef PG8_SA
#undef PG8_SB
#undef PG8_STAGE
#undef PG8_LDA
#undef PG8_LDB
#undef PG8_MMA
#undef PG8_WAIT_V
#undef PG8_WAIT_L
#undef PG8_BAR
#undef PG8_SCHED
#undef PG8_APTR
#undef PG8_BPTR
}
}

typedef f32x4 AccT[2][2][4][2];

__device__ __forceinline__ u32x4 pack8s(f32x4 a, f32x4 b, float s) {
    u32x4 w; w.x = cvt_pk_bf16(a[0] * s, a[1] * s); w.y = cvt_pk_bf16(a[2] * s, a[3] * s); w.z = cvt_pk_bf16(b[0] * s, b[1] * s); w.w = cvt_pk_bf16(b[2] * s, b[3] * s); return w;
}

struct EpiIn {
    static constexpr bool PERM = true;
    bf16_t* Z; float* ssqp; bf16_t* Kr; float* lf; const float* cosT; const float* sinT; const float* bfg;
    __device__ __forceinline__ void operator()(const AccT& acc, const pg8::Unit& u, int wr, int wc, int fr, int fq) const {
        const int row0 = u.pm * 256 + wr * 64 + fr;
#pragma unroll
        for (int ai = 0; ai < 2; ++ai)
#pragma unroll
            for (int m = 0; m < 4; ++m) {
                const int row = row0 + ai * 128 + m * 16;
                const float rs = 1.0f;
                if (u.pn < 20) {
                    float ss = 0.f;
#pragma unroll
                    for (int bj = 0; bj < 2; ++bj) {
                        const f32x4 a = acc[ai][bj][m][0], b = acc[ai][bj][m][1];
                        *(u32x4*)(Z + (size_t)row * ZLD + u.pn * 256 + bj * 128 + wc * 32 + 8 * fq) = pack8s(a, b, rs);
#pragma unroll
                        for (int j = 0; j < 4; ++j) ss += a[j] * a[j] + b[j] * b[j];
                    }
                    if (u.pn < 4) {
                        ss *= rs * rs;
                        ss += __shfl_xor(ss, 16); ss += __shfl_xor(ss, 32);
                        if (fq == 0) ssqp[row * 16 + u.pn * 4 + wc] = ss;
                    }
                } else {
                    if (wc == 0) {
                        const f32x4 c0 = *(const f32x4*)(cosT + row * 32 + 8 * fq), c1 = *(const f32x4*)(cosT + row * 32 + 8 * fq + 4);
                        const f32x4 s0 = *(const f32x4*)(sinT + row * 32 + 8 * fq), s1 = *(const f32x4*)(sinT + row * 32 + 8 * fq + 4);
                        const f32x4 x1a = acc[ai][0][m][0] * rs, x1b = acc[ai][0][m][1] * rs, x2a = acc[ai][1][m][0] * rs, x2b = acc[ai][1][m][1] * rs;
                        const f32x4 y1a = x1a * c0 - x2a * s0, y1b = x1b * c1 - x2b * s1, y2a = x2a * c0 + x1a * s0, y2b = x2b * c1 + x1b * s1;
                        *(u32x4*)(Kr + (size_t)row * 64 + 8 * fq) = pack8s(y1a, y1b, 1.0f);
                        *(u32x4*)(Kr + (size_t)row * 64 + 32 + 8 * fq) = pack8s(y2a, y2b, 1.0f);
                    } else if (wc == 1 && fq == 0) {
#pragma unroll
                        for (int n = 0; n < 2; ++n)
#pragma unroll
                            for (int j = 0; j < 4; ++j) {
                                const float x = acc[ai][0][m][n][j] * rs + bfg[4 * n + j];
                                lf[(4 * n + j) * MROWS + row] = fminf(x, 0.f) - log1pf(__expf(-fabsf(x)));
                            }
                    }
                }
            }
    }
};

struct EpiUp {
    static constexpr bool PERM = true;
    bf16_t* Qm; bf16_t* KV; const float* ssqp; const float* cosT; const float* sinT;
    __device__ __forceinline__ float ssq8(int row, int which) const { const f32x4 a = *(const f32x4*)(ssqp + row * 16 + which * 8), b = *(const f32x4*)(ssqp + row * 16 + which * 8 + 4); return ((a[0] + a[1]) + (a[2] + a[3])) + ((b[0] + b[1]) + (b[2] + b[3])); }
    __device__ __forceinline__ void operator()(const AccT& acc, const pg8::Unit& u, int wr, int wc, int fr, int fq) const {
        const int row0 = u.pm * 256 + wr * 64 + fr;
#pragma unroll
        for (int ai = 0; ai < 2; ++ai)
#pragma unroll
            for (int m = 0; m < 4; ++m) {
                const int row = row0 + ai * 128 + m * 16;
                if (u.pn < 4) {
                    const float rs = rsqrtf(ssq8(row, 0) * (1.0f / 512) + EPSN) * QS_MLA;
#pragma unroll
                    for (int bj = 0; bj < 2; ++bj)
                        *(u32x4*)(Qm + (size_t)row * 1536 + (2 * u.pn + bj) * 192 + wc * 32 + 8 * fq) = pack8s(acc[ai][bj][m][0], acc[ai][bj][m][1], rs);
                } else if (u.pn < 6) {
                    const float rs = rsqrtf(ssq8(row, 0) * (1.0f / 512) + EPSN) * QS_MLA;
                    const int head = 4 * (u.pn - 4) + wc;
                    const f32x4 c0 = *(const f32x4*)(cosT + row * 32 + 8 * fq), c1 = *(const f32x4*)(cosT + row * 32 + 8 * fq + 4);
                    const f32x4 s0 = *(const f32x4*)(sinT + row * 32 + 8 * fq), s1 = *(const f32x4*)(sinT + row * 32 + 8 * fq + 4);
                    const f32x4 x1a = acc[ai][0][m][0] * rs, x1b = acc[ai][0][m][1] * rs, x2a = acc[ai][1][m][0] * rs, x2b = acc[ai][1][m][1] * rs;
                    const f32x4 y1a = x1a * c0 - x2a * s0, y1b = x1b * c1 - x2b * s1, y2a = x2a * c0 + x1a * s0, y2b = x2b * c1 + x1b * s1;
                    *(u32x4*)(Qm + (size_t)row * 1536 + head * 192 + 128 + 8 * fq) = pack8s(y1a, y1b, 1.0f);
                    *(u32x4*)(Qm + (size_t)row * 1536 + head * 192 + 160 + 8 * fq) = pack8s(y2a, y2b, 1.0f);
                } else {
                    const float rs = rsqrtf(ssq8(row, 1) * (1.0f / 512) + EPSN);
#pragma unroll
                    for (int bj = 0; bj < 2; ++bj)
                        *(u32x4*)(KV + (size_t)row * 2048 + (u.pn - 6) * 256 + bj * 128 + wc * 32 + 8 * fq) = pack8s(acc[ai][bj][m][0], acc[ai][bj][m][1], rs);
                }
            }
    }
};

struct EpiF32 {
    static constexpr bool PERM = true;
    bf16_t* C; float* Part;
    __device__ __forceinline__ void operator()(const AccT& acc, const pg8::Unit& u, int wr, int wc, int fr, int fq) const {
        const int row0 = u.pm * 256 + wr * 64 + fr, col0 = u.pn * 256 + wc * 32 + 8 * fq;
        if (u.part >= 0) {
            if (wr == 1) { float* rowp = Part + (size_t)(u.part * 16 + fr) * DM + col0;
#pragma unroll
                for (int bj = 0; bj < 2; ++bj)
#pragma unroll
                    for (int n = 0; n < 2; ++n) *(f32x4*)(rowp + bj * 128 + n * 4) = acc[1][bj][3][n]; }
            return;
        }
#pragma unroll
        for (int ai = 0; ai < 2; ++ai)
#pragma unroll
            for (int m = 0; m < 4; ++m) { bf16_t* rowp = C + (size_t)(row0 + ai * 128 + m * 16) * DM + col0;
#pragma unroll
                for (int bj = 0; bj < 2; ++bj) *(u32x4*)(rowp + bj * 128) = pack8s(acc[ai][bj][m][0], acc[ai][bj][m][1], 1.0f); }
    }
};

struct EpiU {
    static constexpr bool PERM = true;
    bf16_t* U;
    __device__ __forceinline__ void operator()(const AccT& acc, const pg8::Unit& u, int wr, int wc, int fr, int fq) const {
        const int row0 = u.pm * 256 + wr * 64 + fr;
#pragma unroll
        for (int ai = 0; ai < 2; ++ai)
#pragma unroll
            for (int m = 0; m < 4; ++m) {
                const int row = row0 + ai * 128 + m * 16;
                const float rs = 1.0f;
#pragma unroll
                for (int bj = 0; bj < 2; ++bj)
                    *(u32x4*)(U + (size_t)row * DFF2 + u.pn * 256 + bj * 128 + wc * 32 + 8 * fq) = pack8s(acc[ai][bj][m][0], acc[ai][bj][m][1], rs);
            }
    }
};

__device__ __forceinline__ int srccol_in(int n) {
    if (n < 1024) return n;
    if (n < 5120) return n + 64;
    const int c = n - 5120;
    if (c < 32) return 1024 + c;
    if (c < 40) return 5184 + (c - 32);
    if (c >= 128 && c < 160) return 1056 + (c - 128);
    return -1;
}
__device__ __forceinline__ int srccol_qup(int n) {
    if (n < 1024) return (n >> 7) * 192 + (n & 127);
    const int r = n - 1024, t = r >> 8, c = r & 255, half = c >> 7, hh = (c & 127) >> 5, i = c & 31;
    return (4 * t + hh) * 192 + 128 + half * 32 + i;
}
constexpr int CT_IN = 16 * 42, CT_QUP = 4 * 12, CT_KVUP = 4 * 16, CT_OUT = 16 * 16, CT_UP = 16 * 88, CT_DOWN = 44 * 16;
constexpr int CT_LAYER = CT_IN + CT_QUP + CT_KVUP + CT_OUT + CT_UP + CT_DOWN;

struct CvtJob { const float* W; const float* gain; bf16_t* dst; int K, Nsrc, mat, k0, n0; };
__device__ __forceinline__ CvtJob cvt_decode(const Params& p, int job) {
    CvtJob j; j.gain = nullptr;
    const int layer = job / CT_LAYER; int r = job % CT_LAYER;
    unsigned char* wl = p.ws + WS_W + (size_t)layer * WL_SIZE;
    if (r < CT_IN) { j.mat = 0; j.K = 2048; j.Nsrc = INC; j.W = p.in[I_WIN] + (size_t)layer * 2048 * INC; j.gain = p.in[I_LNMIXPRE] + layer * 2048; j.dst = (bf16_t*)(wl + WL_IN); }
    else if ((r -= CT_IN) < CT_QUP) { j.mat = 1; j.K = 512; j.Nsrc = 1536; j.W = p.in[I_WQUP] + (size_t)layer * 512 * 1536; j.gain = p.in[I_GQL] + layer * 512; j.dst = (bf16_t*)(wl + WL_QUP); }
    else if ((r -= CT_QUP) < CT_KVUP) { j.mat = 2; j.K = 512; j.Nsrc = 2048; j.W = p.in[I_WKVUP] + (size_t)layer * 512 * 2048; j.gain = p.in[I_GKVL] + layer * 512; j.dst = (bf16_t*)(wl + WL_KVUP); }
    else if ((r -= CT_KVUP) < CT_OUT) { j.mat = 3; j.K = 2048; j.Nsrc = 2048; j.W = p.in[I_WOUT] + (size_t)layer * 2048 * 2048; j.dst = (bf16_t*)(wl + WL_OUT); }
    else if ((r -= CT_OUT) < CT_UP) { j.mat = 4; j.K = 2048; j.Nsrc = DFF2; j.W = p.in[I_WUP] + (size_t)layer * 2048 * DFF2; j.gain = p.in[I_LNFFNPRE] + layer * 2048; j.dst = (bf16_t*)(wl + WL_UP); }
    else { r -= CT_UP; j.mat = 5; j.K = DFF; j.Nsrc = 2048; j.W = p.in[I_WDOWN] + (size_t)layer * DFF * 2048; j.dst = (bf16_t*)(wl + WL_DOWN); }
    const int nKt = j.K / 128, kt = r % nKt, ntile = r / nKt; j.k0 = kt * 128; j.n0 = ntile * 128;
    return j;
}
__device__ __forceinline__ void cvt_load(const CvtJob& j, int tid, f32x4 (&v)[8], float (&gk)[8]) {
    const int nq = tid & 31, kk = tid >> 5, nd = j.n0 + 4 * nq;
    const int sc = j.mat == 0 ? srccol_in(nd) : (j.mat == 1 ? srccol_qup(nd) : nd);
#pragma unroll
    for (int i = 0; i < 8; ++i) {
        const int k = kk + 16 * i;
        v[i] = (f32x4){0.f, 0.f, 0.f, 0.f};
        if (sc >= 0) v[i] = __builtin_nontemporal_load((const f32x4*)(j.W + (size_t)(j.k0 + k) * j.Nsrc + sc));
        gk[i] = j.gain ? j.gain[j.k0 + k] : 1.0f;
    }
}
__device__ __forceinline__ void cvt_store(const CvtJob& j, int tid, const f32x4 (&v)[8], const float (&gk)[8], LAS unsigned char* lds) {
    LAS bf16_t* T = (LAS bf16_t*)lds;
    {
        const int nq = tid & 31, kk = tid >> 5;
#pragma unroll
        for (int i = 0; i < 8; ++i) {
            const int k = kk + 16 * i;
#pragma unroll
            for (int jj = 0; jj < 4; ++jj) { const unsigned w = cvt_pk_bf16(v[i][jj] * gk[i], 0.f); T[(jj * 32 + nq) * 130 + k] = (bf16_t)(w & 0xffffu); }
        }
    }
    __syncthreads();
    {
        const int n = tid >> 2, kc = tid & 3, rs_ = (n & 3) * 32 + (n >> 2);
        const LAS unsigned* T32 = (const LAS unsigned*)lds;
        bf16_t* d = j.dst + (size_t)(j.n0 + n) * j.K + j.k0 + kc * 32;
#pragma unroll
        for (int h2 = 0; h2 < 4; ++h2) {
            u32x4 w;
            w.x = T32[rs_ * 65 + kc * 16 + h2 * 4 + 0]; w.y = T32[rs_ * 65 + kc * 16 + h2 * 4 + 1]; w.z = T32[rs_ * 65 + kc * 16 + h2 * 4 + 2]; w.w = T32[rs_ * 65 + kc * 16 + h2 * 4 + 3];
            *(u32x4*)(d + h2 * 8) = w;
        }
    }
    __syncthreads();
}
constexpr int GAP_PRE = 1300, GAP_J1 = 11, GAP_J6 = 13, GAP_BASE6 = GAP_PRE + 75 * GAP_J1;
constexpr int PREP_JOBS = CT_LAYER + (NLAYER - 1) * GAP_PRE;
template <bool PREPMAP> __device__ __forceinline__ int cvt_map(int q) {
    if (!PREPMAP || q < CT_LAYER) return q;
    const int r = q - CT_LAYER; return (1 + r / GAP_PRE) * CT_LAYER + r % GAP_PRE;
}
template <bool PREPMAP>
__device__ __forceinline__ void convert_jobs(const Params& p, int job0, int job_end, int stride, LAS unsigned char* lds) {
    if (job0 >= job_end) return;
    const int tid = opaque_tid();
    int job = job0;
    CvtJob cur = cvt_decode(p, cvt_map<PREPMAP>(job));
    f32x4 v[8]; float gk[8];
    cvt_load(cur, tid, v, gk);
    for (;;) {
        const int nj = job + stride; const bool more = nj < job_end;
        CvtJob nxt = cur; f32x4 v2[8]; float gk2[8];
        if (more) { nxt = cvt_decode(p, cvt_map<PREPMAP>(nj)); cvt_load(nxt, tid, v2, gk2); }
        cvt_store(cur, tid, v, gk, lds);
        if (!more) break;
#pragma unroll
        for (int i = 0; i < 8; ++i) { v[i] = v2[i]; gk[i] = gk2[i]; }
        cur = nxt; job = nj;
    }
}

__device__ __forceinline__ void phase_prep(const Params& p, LAS unsigned char* lds) {
    const int tid = opaque_tid(), G = gridDim.x, b = blockIdx.x;
    const int gtid = b * NTHREADS + tid, nthr = G * NTHREADS;
    if (gtid < 64) ((int*)(p.ws + WS_CTR))[gtid] = 0;
    { float* cosT = (float*)(p.ws + WS_COS); float* sinT = (float*)(p.ws + WS_SIN);
      for (int i = gtid; i < MROWS * 32; i += nthr) {
          const int row_ = i >> 5, f = i & 31, pos = row_ < PADR ? 0 : row_ - PADR;
          const float invf = exp2f(-(float)f * (13.287712379549449f / 32.0f));
          const float ang = (float)pos * invf;
          const double rev = (double)ang * 0.15915494309189535;
          const float fr = (float)(rev - floor(rev));
          cosT[i] = __builtin_amdgcn_cosf(fr); sinT[i] = __builtin_amdgcn_sinf(fr);
      } }
    { const int lane = tid & 63, gw = gtid >> 6, nw = nthr >> 6;
      bf16_t* abf = (bf16_t*)(p.ws + WS_ABF);
      for (int row = gw; row < MROWS; row += nw) {
          const float* src = row < PADR ? nullptr : (row < FRAME0 ? p.in[I_META] + (size_t)(row - PADR) * DM : p.in[I_X] + (size_t)(row - FRAME0) * DM);
          float ss = 0.f; f32x4 v[8];
#pragma unroll
          for (int i = 0; i < 8; ++i) {
              const int c = lane * 4 + 256 * i;
              v[i] = (f32x4){0.f, 0.f, 0.f, 0.f};
              if (src) v[i] = __builtin_nontemporal_load((const f32x4*)(src + c));
              ss += v[i][0] * v[i][0] + v[i][1] * v[i][1] + v[i][2] * v[i][2] + v[i][3] * v[i][3];
          }
          ss = wave_sum(ss);
          const float rs = rsqrtf(ss * (1.0f / DM) + EPSN);
#pragma unroll
          for (int i = 0; i < 8; ++i) {
              u32x2 w; w.x = cvt_pk_bf16(v[i][0] * rs, v[i][1] * rs); w.y = cvt_pk_bf16(v[i][2] * rs, v[i][3] * rs);
              *(u32x2*)(abf + (size_t)row * DM + lane * 4 + 256 * i) = w;
          }
      } }
    convert_jobs<true>(p, b, PREP_JOBS, G, lds);
}

__device__ __forceinline__ void phase_resid(const Params& p, const float* g, bool first, bool last, int nsplit) {
    const int tid = opaque_tid(), lane = tid & 63, gw = (blockIdx.x * NTHREADS + tid) >> 6, nw = (gridDim.x * NTHREADS) >> 6;
    float* h = (float*)(p.ws + WS_H); bf16_t* abf = (bf16_t*)(p.ws + WS_ABF);
    const bf16_t* mix = (const bf16_t*)(p.ws + WS_MIX);
    const float* part = (const float*)(p.ws + WS_PART);
    f32x4 gv[8];
#pragma unroll
    for (int i = 0; i < 8; ++i) gv[i] = *(const f32x4*)(g + lane * 4 + 256 * i);
#define HROW(r) (first ? ((r) < FRAME0 ? p.in[I_META] + (size_t)((r) - PADR) * DM : p.in[I_X] + (size_t)((r) - FRAME0) * DM) : (const float*)h + (size_t)(r) * DM)
#define RESID_ROW(row, MV, HV) do { \
        float ss = 0.f; \
        _Pragma("unroll") for (int i = 0; i < 8; ++i) ss += MV[i][0] * MV[i][0] + MV[i][1] * MV[i][1] + MV[i][2] * MV[i][2] + MV[i][3] * MV[i][3]; \
        ss = wave_sum(ss); \
        const float rs = rsqrtf(ss * (1.0f / DM) + EPSN); \
        float s2 = 0.f; \
        _Pragma("unroll") for (int i = 0; i < 8; ++i) { \
            const int c = lane * 4 + 256 * i; \
            const f32x4 o = HV[i] + MV[i] * rs * gv[i]; \
            if (!last) *(f32x4*)(h + (size_t)(row) * DM + c) = o; \
            HV[i] = o; \
            s2 += o[0] * o[0] + o[1] * o[1] + o[2] * o[2] + o[3] * o[3]; \
            if (last && (row) >= FRAME0) *(f32x4*)(p.out + (size_t)((row) - FRAME0) * DM + c) = o; \
        } \
        if (last) break; \
        s2 = wave_sum(s2); \
        const float rs2 = rsqrtf(s2 * (1.0f / DM) + EPSN);            \
        _Pragma("unroll") for (int i = 0; i < 8; ++i) { \
            u32x2 w; w.x = cvt_pk_bf16(HV[i][0] * rs2, HV[i][1] * rs2); w.y = cvt_pk_bf16(HV[i][2] * rs2, HV[i][3] * rs2); \
            *(u32x2*)(abf + (size_t)(row) * DM + lane * 4 + 256 * i) = w; \
        } } while (0)
    if (gw < 16) {
        const int row = PADR + gw;
        f32x4 mv[8], hv[8];
#pragma unroll
        for (int i = 0; i < 8; ++i) { mv[i] = (f32x4){0.f, 0.f, 0.f, 0.f}; hv[i] = *(const f32x4*)(HROW(row) + lane * 4 + 256 * i); }
        for (int sp = 0; sp < nsplit; ++sp) {
#pragma unroll
            for (int i = 0; i < 8; ++i) mv[i] += *(const f32x4*)(part + (size_t)(sp * 16 + gw) * DM + lane * 4 + 256 * i);
        }
        RESID_ROW(row, mv, hv);
    }
    int row = FRAME0 + (nw - 1 - gw);
    if (row < MROWS) {
        f32x4 mv[8], hv[8];
#pragma unroll
        for (int i = 0; i < 8; ++i) { const u32x2 mw = __builtin_nontemporal_load((const u32x2*)(mix + (size_t)row * DM + lane * 4 + 256 * i)); mv[i] = (f32x4){bf_lo(mw.x), bf_hi(mw.x), bf_lo(mw.y), bf_hi(mw.y)}; hv[i] = *(const f32x4*)(HROW(row) + lane * 4 + 256 * i); }
        for (;;) {
            const int nrow = row + nw; const bool more = nrow < MROWS;
            f32x4 mv2[8], hv2[8];
            if (more) {
#pragma unroll
                for (int i = 0; i < 8; ++i) { const u32x2 mw = __builtin_nontemporal_load((const u32x2*)(mix + (size_t)nrow * DM + lane * 4 + 256 * i)); mv2[i] = (f32x4){bf_lo(mw.x), bf_hi(mw.x), bf_lo(mw.y), bf_hi(mw.y)}; hv2[i] = *(const f32x4*)(HROW(nrow) + lane * 4 + 256 * i); }
            }
            RESID_ROW(row, mv, hv);
            if (!more) break;
#pragma unroll
            for (int i = 0; i < 8; ++i) { mv[i] = mv2[i]; hv[i] = hv2[i]; }
            row = nrow;
        }
    }
#undef RESID_ROW
#undef HROW
}

__device__ __forceinline__ void foxnorm_half(const u32x4 a, const u32x4 b2, const float* gg, float qs, bf16_t* dst) {
    float v[16]; unpack8(a, v); unpack8(b2, v + 8);
    float ss = 0.f;
#pragma unroll
    for (int j = 0; j < 16; ++j) ss += v[j] * v[j];
    ss += __shfl_xor(ss, 1); ss += __shfl_xor(ss, 2); ss += __shfl_xor(ss, 4);
    const float rs = rsqrtf(ss * (1.0f / 128) + EPSN) * qs;
    u32x4 o0, o1;
    o0.x = cvt_pk_bf16(v[0] * rs * gg[0], v[1] * rs * gg[1]); o0.y = cvt_pk_bf16(v[2] * rs * gg[2], v[3] * rs * gg[3]);
    o0.z = cvt_pk_bf16(v[4] * rs * gg[4], v[5] * rs * gg[5]); o0.w = cvt_pk_bf16(v[6] * rs * gg[6], v[7] * rs * gg[7]);
    o1.x = cvt_pk_bf16(v[8] * rs * gg[8], v[9] * rs * gg[9]); o1.y = cvt_pk_bf16(v[10] * rs * gg[10], v[11] * rs * gg[11]);
    o1.z = cvt_pk_bf16(v[12] * rs * gg[12], v[13] * rs * gg[13]); o1.w = cvt_pk_bf16(v[14] * rs * gg[14], v[15] * rs * gg[15]);
    *(u32x4*)dst = o0; *(u32x4*)(dst + 8) = o1;
}
__device__ __forceinline__ void phase_foxnorm(const Params& p, int layer) {
    const int tid = opaque_tid(), lane = tid & 63, gw = (blockIdx.x * NTHREADS + tid) >> 6, nw = (gridDim.x * NTHREADS) >> 6;
    const bf16_t* Z = (const bf16_t*)(p.ws + WS_Z); bf16_t* Qf = (bf16_t*)(p.ws + WS_QF); bf16_t* Kf = (bf16_t*)(p.ws + WS_KF);
    const int d0 = (lane & 7) * 16;
    float gq[16], gk[16];
#pragma unroll
    for (int j = 0; j < 16; j += 4) { *(f32x4*)&gq[j] = *(const f32x4*)(p.in[I_GFQ] + layer * 128 + d0 + j); *(f32x4*)&gk[j] = *(const f32x4*)(p.in[I_GFK] + layer * 128 + d0 + j); }
    int row = gw;
    if (row >= MROWS) return;
    const bf16_t* src = Z + (size_t)row * ZLD + 1024 + lane * 16;
    u32x4 qa = __builtin_nontemporal_load((const u32x4*)src), qb = __builtin_nontemporal_load((const u32x4*)(src + 8)), ka = __builtin_nontemporal_load((const u32x4*)(src + 1024)), kb2 = __builtin_nontemporal_load((const u32x4*)(src + 1032));
    for (;;) {
        const int nrow = row + nw; const bool more = nrow < MROWS;
        u32x4 qa2, qb2, ka2, kb3;
        if (more) { const bf16_t* s2 = Z + (size_t)nrow * ZLD + 1024 + lane * 16; qa2 = __builtin_nontemporal_load((const u32x4*)s2); qb2 = __builtin_nontemporal_load((const u32x4*)(s2 + 8)); ka2 = __builtin_nontemporal_load((const u32x4*)(s2 + 1024)); kb3 = __builtin_nontemporal_load((const u32x4*)(s2 + 1032)); }
        foxnorm_half(qa, qb, gq, QS_FOX, Qf + (size_t)row * 1024 + lane * 16);
        foxnorm_half(ka, kb2, gk, 1.0f, Kf + (size_t)row * 1024 + lane * 16);
        if (!more) break;
        qa = qa2; qb = qb2; ka = ka2; kb2 = kb3; row = nrow;
    }
}

__device__ __forceinline__ void phase_scan(const Params& p, int head, LAS unsigned char* lds) {
    const int tid = opaque_tid(), lane = tid & 63, wid = tid >> 6;
    const float* lf = (const float*)(p.ws + WS_LF) + (size_t)head * MROWS; float* bk = (float*)(p.ws + WS_BK) + (size_t)head * MROWS;
    LAS float* wt = (LAS float*)lds;
    const int r0 = tid * 17;
    float v[17]; float s = 0.f;
#pragma unroll
    for (int i = 0; i < 17; ++i) { const int r = r0 + i; v[i] = r < MROWS ? lf[r] : 0.f; }
#pragma unroll
    for (int i = 0; i < 17; ++i) s += v[i];
    float inc = s;
#pragma unroll
    for (int o = 1; o < 64; o <<= 1) { const float t = __shfl_up(inc, o); if (lane >= o) inc += t; }
    if (lane == 63) wt[wid] = inc;
    __syncthreads();
    float base = 0.f;
    for (int w = 0; w < wid; ++w) base += wt[w];
    float run = base + inc - s;
#pragma unroll
    for (int i = 0; i < 17; ++i) { const int r = r0 + i; run += v[i]; if (r < MROWS) bk[r] = -run * LOG2E; }
    __syncthreads();
}

__device__ __forceinline__ float gelu_tanh(float x) {
    const float y = 0.7978845608028654f * (x + 0.044715f * x * x * x);
    return x * __builtin_amdgcn_rcpf(1.0f + __builtin_amdgcn_exp2f(-2.0f * LOG2E * y));
}
__device__ __forceinline__ void phase_conv(const Params& p, int layer) {
    const bf16_t* U = (const bf16_t*)(p.ws + WS_U); bf16_t* Gd = (bf16_t*)(p.ws + WS_G);
    const float* wc = p.in[I_WCONV] + (size_t)layer * 3 * DFF2; const float* bc = p.in[I_BCONV] + (size_t)layer * DFF2;
    const int gtid = blockIdx.x * NTHREADS + opaque_tid(), nthr = gridDim.x * NTHREADS;
    constexpr int NCV = DFF / 8, RCH = 16, NCH = MROWS / RCH;
    for (int task = gtid; task < NCV * NCH; task += nthr) {
        const int cv = task % NCV, ch = task / NCV, c = cv * 8, r0 = ch * RCH;
        float wg[3][8], wu[3][8], bg[8], bu[8];
#pragma unroll
        for (int j = 0; j < 3; ++j)
#pragma unroll
            for (int e = 0; e < 8; e += 4) { *(f32x4*)&wg[j][e] = *(const f32x4*)(wc + j * DFF2 + c + e); *(f32x4*)&wu[j][e] = *(const f32x4*)(wc + j * DFF2 + DFF + c + e); }
#pragma unroll
        for (int e = 0; e < 8; e += 4) { *(f32x4*)&bg[e] = *(const f32x4*)(bc + c + e); *(f32x4*)&bu[e] = *(const f32x4*)(bc + DFF + c + e); }
        float g2[8], g1[8], u2[8], u1[8];
        if (r0 >= 2) {
            unpack8(__builtin_nontemporal_load((const u32x4*)(U + (size_t)(r0 - 2) * DFF2 + c)), g2); unpack8(__builtin_nontemporal_load((const u32x4*)(U + (size_t)(r0 - 2) * DFF2 + DFF + c)), u2);
            unpack8(__builtin_nontemporal_load((const u32x4*)(U + (size_t)(r0 - 1) * DFF2 + c)), g1); unpack8(__builtin_nontemporal_load((const u32x4*)(U + (size_t)(r0 - 1) * DFF2 + DFF + c)), u1);
        } else {
#pragma unroll
            for (int e = 0; e < 8; ++e) { g2[e] = 0.f; g1[e] = 0.f; u2[e] = 0.f; u1[e] = 0.f; }
        }
#pragma unroll
        for (int rb = 0; rb < RCH; rb += 8) {
            u32x4 gr[8], ur[8];
#pragma unroll
            for (int k = 0; k < 8; ++k) { gr[k] = __builtin_nontemporal_load((const u32x4*)(U + (size_t)(r0 + rb + k) * DFF2 + c)); ur[k] = __builtin_nontemporal_load((const u32x4*)(U + (size_t)(r0 + rb + k) * DFF2 + DFF + c)); }
#pragma unroll
            for (int k = 0; k < 8; ++k) {
                float g0[8], u0[8]; unpack8(gr[k], g0); unpack8(ur[k], u0);
                float o[8];
#pragma unroll
                for (int e = 0; e < 8; ++e) {
                    const float gp = bg[e] + wg[0][e] * g2[e] + wg[1][e] * g1[e] + wg[2][e] * g0[e];
                    const float up = bu[e] + wu[0][e] * u2[e] + wu[1][e] * u1[e] + wu[2][e] * u0[e];
                    o[e] = gelu_tanh(gp) * up;
                    g2[e] = g1[e]; g1[e] = g0[e]; u2[e] = u1[e]; u1[e] = u0[e];
                }
                u32x4 w; w.x = cvt_pk_bf16(o[0], o[1]); w.y = cvt_pk_bf16(o[2], o[3]); w.z = cvt_pk_bf16(o[4], o[5]); w.w = cvt_pk_bf16(o[6], o[7]);
                *(u32x4*)(Gd + (size_t)(r0 + rb + k) * DFF + c) = w;
            }
        }
    }
}

constexpr int SHM_V = 64 * 128 * 2;
__device__ __forceinline__ int v_st(int k, int c) { const int kk = (k & ~0xC) | ((k & 4) << 1) | ((k & 8) >> 1); return ((kk >> 3) * 4 + (c >> 5)) * 512 + ((kk & 7) * 32 + (c & 31)) * 2; }
__device__ __forceinline__ int v_rd_base(int lane) { return ((lane & 3) << 3) | (((lane >> 2) & 3) << 6) | (((lane >> 4) & 1) << 5) | (((lane >> 5) & 1) << 8); }
constexpr int v_rd_off(int d0, int ks, int half) { return d0 * 512 + ks * 4096 + half * 2048; }
__device__ __forceinline__ int crow(int r, int hi) { return (r & 3) + 8 * (r >> 2) + 4 * hi; }
#define SBAR() __builtin_amdgcn_sched_barrier(0)

template <int VB>
__device__ __forceinline__ void pv_tile(f32x16* o, int vb0, bf16x8 pa0, bf16x8 pa1, bf16x8 pa2, bf16x8 pa3) {
#define TRRD(dst, off) asm volatile("ds_read_b64_tr_b16 %0, %1 offset:%2" : "=&v"(dst) : "v"(vb0), "i"(off) : "memory")
#define PV_D0(d0) do { s16x4 l0, l1, l2, l3, h0, h1, h2, h3; constexpr int b_ = VB * SHM_V + v_rd_off(d0, 0, 0); \
        TRRD(l0, b_); TRRD(h0, b_ + 2048); TRRD(l1, b_ + 4096); TRRD(h1, b_ + 6144); TRRD(l2, b_ + 8192); TRRD(h2, b_ + 10240); TRRD(l3, b_ + 12288); TRRD(h3, b_ + 14336); \
        asm volatile("s_waitcnt lgkmcnt(0)" ::: "memory"); SBAR(); \
        o[d0] = __builtin_amdgcn_mfma_f32_32x32x16_bf16(pa0, (bf16x8){l0[0], l0[1], l0[2], l0[3], h0[0], h0[1], h0[2], h0[3]}, o[d0], 0, 0, 0); \
        o[d0] = __builtin_amdgcn_mfma_f32_32x32x16_bf16(pa1, (bf16x8){l1[0], l1[1], l1[2], l1[3], h1[0], h1[1], h1[2], h1[3]}, o[d0], 0, 0, 0); \
        o[d0] = __builtin_amdgcn_mfma_f32_32x32x16_bf16(pa2, (bf16x8){l2[0], l2[1], l2[2], l2[3], h2[0], h2[1], h2[2], h2[3]}, o[d0], 0, 0, 0); \
        o[d0] = __builtin_amdgcn_mfma_f32_32x32x16_bf16(pa3, (bf16x8){l3[0], l3[1], l3[2], l3[3], h3[0], h3[1], h3[2], h3[3]}, o[d0], 0, 0, 0); } while (0)
    PV_D0(0); PV_D0(1); PV_D0(2); PV_D0(3);
#undef PV_D0
#undef TRRD
}

template <int TYPE>
__device__ __forceinline__ void attn_item(const Params& p, int layer, int head, int qb, int mode, LAS unsigned char* lds) {
    constexpr int DQK = TYPE == 0 ? 192 : 128, NQ = DQK / 16, SHM_K = 64 * DQK * 2;
    constexpr int OFF_K = 2 * SHM_V, OFF_B = OFF_K + 2 * SHM_K;
    const int tid = opaque_tid(), wid = __builtin_amdgcn_readfirstlane(tid >> 6), lane = tid & 63, r32 = lane & 31, hi = lane >> 5;
    const int P0 = qb * 256, qrow = P0 + wid * 32 + r32;
    const bf16_t* Qb; int ldq; const bf16_t* Kn; int ldk; const bf16_t* Vp; int ldv;
    if (TYPE == 0) { Qb = (const bf16_t*)(p.ws + WS_QM) + head * 192; ldq = 1536; Kn = (const bf16_t*)(p.ws + WS_KV) + head * 256; ldk = 2048; Vp = Kn + 128; ldv = 2048; }
    else { Qb = (const bf16_t*)(p.ws + WS_QF) + head * 128; ldq = 1024; Kn = (const bf16_t*)(p.ws + WS_KF) + head * 128; ldk = 1024; Vp = (const bf16_t*)(p.ws + WS_Z) + 3072 + head * 128; ldv = ZLD; }
    const bf16_t* Krp = (const bf16_t*)(p.ws + WS_KR);
    const float* bias = (const float*)(p.ws + WS_BK) + (size_t)head * MROWS;
#define KMAX(pos) (TYPE == 0 ? ((pos) | 63) : (pos))
    const int my_kmax = KMAX(qrow);
    const int w_first = KMAX(P0 + wid * 32), w_last = KMAX(P0 + wid * 32 + 31);
    int blk_kmax = KMAX(P0 + 255); if (blk_kmax > MROWS - 1) blk_kmax = MROWS - 1;
    const int NT = blk_kmax / 64 + 1;
    bf16x8 qr[NQ];
#pragma unroll
    for (int d0 = 0; d0 < NQ; ++d0) qr[d0] = *(const bf16x8*)(Qb + (size_t)qrow * ldq + d0 * 16 + hi * 8);
    LAS unsigned char* V_lds = lds; LAS unsigned char* K_lds = lds + OFF_K; LAS float* B_lds = (LAS float*)(lds + OFF_B);
    LAS float* wsl = (LAS float*)(lds + LDS_BYTES - 4096) + wid * 64;
    const int vb0 = (int)(unsigned)(uintptr_t)V_lds + v_rd_base(lane);
    unsigned offK[2], offV[2], offR;
#pragma unroll
    for (int j = 0; j < 2; ++j) {
        const int row = (j * 8 + wid) * 4 + (lane >> 4), ch = (lane & 15) ^ (row & 7);
        offK[j] = (unsigned)(row * ldk + ch * 8) * 2u;
        const int q = (j * 8 + wid) * 64 + lane, sub = q >> 5, kk = (sub >> 2) * 8 + ((q & 31) >> 2), c = (sub & 3) * 32 + (q & 3) * 8;
        const int k = (kk & ~0xC) | ((kk & 4) << 1) | ((kk & 8) >> 1);
        offV[j] = (unsigned)(k * ldv + c) * 2u;
    }
    { const int row = wid * 8 + (lane >> 3), ch = (lane & 7) ^ (row & 7); offR = (unsigned)(row * 64 + ch * 8) * 2u; }
#define ADMA(t, bf) do { const size_t k0_ = (size_t)(t) * 64; \
        const char* kp_ = (const char*)(Kn + k0_ * ldk); const char* vp_ = (const char*)(Vp + k0_ * ldv); \
        _Pragma("unroll") for (int j_ = 0; j_ < 2; ++j_) { \
            __builtin_amdgcn_global_load_lds((const unsigned*)(kp_ + offK[j_]), (LAS unsigned*)(K_lds + (bf) * SHM_K + (j_ * 8 + wid) * 1024), 16, 0, 0); \
            __builtin_amdgcn_global_load_lds((const unsigned*)(vp_ + offV[j_]), (LAS unsigned*)(V_lds + (bf) * SHM_V + (j_ * 8 + wid) * 1024), 16, 0, 0); } \
        if (TYPE == 0) __builtin_amdgcn_global_load_lds((const unsigned*)((const char*)(Krp + k0_ * 64) + offR), (LAS unsigned*)(K_lds + (bf) * SHM_K + 16384 + wid * 1024), 16, 0, 0); \
        else if (wid == 0) __builtin_amdgcn_global_load_lds((const unsigned*)(bias + k0_ + lane), (LAS unsigned*)(B_lds + (bf) * 64), 4, 0, 0); } while (0)
    float m_reg = -1e30f, l_reg = 0.f; f32x16 o[4];
#pragma unroll
    for (int d = 0; d < 4; ++d) o[d] = (f32x16){};
    constexpr int T0 = PADR / 64;
    int tbeg = T0; float Bb = 0.f;
    if (TYPE == 1) {
        const float* gq = p.in[I_GFQ] + layer * 128; const float* gk = p.in[I_GFK] + layer * 128;
        float gm = fmaxf(fabsf(gq[lane] * gk[lane]), fabsf(gq[lane + 64] * gk[lane + 64]));
#pragma unroll
        for (int o_ = 32; o_ >= 1; o_ >>= 1) gm = fmaxf(gm, __shfl_xor(gm, o_));
        Bb = gm * 11.313708498984761f * LOG2E * 1.02f;
    }
    int tend = NT;
    if (TYPE == 0 && mode != 0) { const int mid = (T0 + NT + 1) >> 1; if (mode == 1) tend = mid; else tbeg = mid; }
    const int ntiles = tend - tbeg, tfirst = TYPE == 1 ? tend - 1 : tbeg;
    LAS float* xm = (LAS float*)(lds + LDS_BYTES - 2048);
    ADMA(tfirst, tfirst & 1);
    asm volatile("s_waitcnt vmcnt(0)" ::: "memory");
    __syncthreads();
    int kb[4], kbr[4];
#pragma unroll
    for (int dd = 0; dd < 4; ++dd) { kb[dd] = r32 * 256 + ((((dd * 2 + hi) ^ (r32 & 7))) << 4); kbr[dd] = 16384 + r32 * 128 + ((((dd * 2 + hi) ^ (r32 & 7))) << 4); }
    for (int it2 = 0; it2 < ntiles; ++it2) {
        const int t = TYPE == 1 ? tfirst - it2 : tfirst + it2, tn = TYPE == 1 ? t - 1 : t + 1;
        const int bf = t & 1, kbase = t * 64;
        if (it2 + 1 < ntiles) { ADMA(tn, bf ^ 1); }
        if (kbase <= w_last) {
            f32x16 p0 = (f32x16){}, p1 = (f32x16){};
            const LAS unsigned char* kt = K_lds + bf * SHM_K;
#pragma unroll
            for (int d0 = 0; d0 < NQ; ++d0) {
                const LAS unsigned char* a = d0 < 8 ? kt + kb[d0 & 3] + (d0 >> 2) * 128 : kt + kbr[d0 & 3];
                const bf16x8 b0 = *(const LAS bf16x8*)a, b1 = *(const LAS bf16x8*)(a + (d0 < 8 ? 32 * 256 : 32 * 128));
                p0 = __builtin_amdgcn_mfma_f32_32x32x16_bf16(b0, qr[d0], p0, 0, 0, 0);
                p1 = __builtin_amdgcn_mfma_f32_32x32x16_bf16(b1, qr[d0], p1, 0, 0, 0);
                if ((d0 & 3) == 3) SBAR();
            }
            if (TYPE == 1) {
                const LAS float* bb = B_lds + bf * 64 + 4 * hi;
#pragma unroll
                for (int q4 = 0; q4 < 4; ++q4) {
                    const f32x4 b0 = *(const LAS f32x4*)(bb + 8 * q4), b1 = *(const LAS f32x4*)(bb + 32 + 8 * q4);
#pragma unroll
                    for (int j = 0; j < 4; ++j) { p0[q4 * 4 + j] += b0[j]; p1[q4 * 4 + j] += b1[j]; }
                }
            }
            if (TYPE == 1 && kbase + 63 > w_first) {
                const int lim = my_kmax - kbase - 4 * hi; const float NEGI = -__builtin_inff();
#pragma unroll
                for (int r = 0; r < 16; ++r) { const int c = (r & 3) + 8 * (r >> 2); if (c > lim) p0[r] = NEGI; if (c + 32 > lim) p1[r] = NEGI; }
            }
            if (t == T0) {
                const int lo = (PADR & 63) - 4 * hi; const float NEGI = -__builtin_inff();
#pragma unroll
                for (int r = 0; r < 16; ++r) { const int c = (r & 3) + 8 * (r >> 2); if (c < lo) p0[r] = NEGI; if (c + 32 < lo) p1[r] = NEGI; }
            }
            float pmax = p0[0];
#pragma unroll
            for (int r = 1; r < 16; ++r) pmax = fmaxf(pmax, p0[r]);
#pragma unroll
            for (int r = 0; r < 16; ++r) pmax = fmaxf(pmax, p1[r]);
            { auto rr = __builtin_amdgcn_permlane32_swap(__float_as_uint(pmax), __float_as_uint(pmax), false, false);
              pmax = fmaxf(__uint_as_float(rr[0]), __uint_as_float(rr[1])); }
            float mn, alpha;
            if (__all((pmax - m_reg) <= (TYPE == 1 ? 2.0f : 11.5f))) { mn = m_reg; alpha = 1.f; }
            else { mn = fmaxf(m_reg, pmax); alpha = __builtin_amdgcn_exp2f(m_reg - mn); m_reg = mn; }
            float ps = 0.f;
#pragma unroll
            for (int r = 0; r < 16; ++r) { p0[r] = __builtin_amdgcn_exp2f(p0[r] - mn); p1[r] = __builtin_amdgcn_exp2f(p1[r] - mn); ps += p0[r] + p1[r]; }
            { auto rr = __builtin_amdgcn_permlane32_swap(__float_as_uint(ps), __float_as_uint(ps), false, false);
              ps = __uint_as_float(rr[0]) + __uint_as_float(rr[1]); }
            l_reg = l_reg * alpha + ps;
            bf16x8 pa0, pa1, pa2, pa3;
#define PK4(P, B_, OUT) do { unsigned a0 = cvt_pk_bf16(P[B_ + 0], P[B_ + 1]), a1 = cvt_pk_bf16(P[B_ + 2], P[B_ + 3]); \
        unsigned b0 = cvt_pk_bf16(P[B_ + 4], P[B_ + 5]), b1 = cvt_pk_bf16(P[B_ + 6], P[B_ + 7]); \
        auto r0 = __builtin_amdgcn_permlane32_swap(a0, b0, false, false); auto r1 = __builtin_amdgcn_permlane32_swap(a1, b1, false, false); \
        u32x4 w = {r0[0], r1[0], r0[1], r1[1]}; OUT = *reinterpret_cast<bf16x8*>(&w); } while (0)
            PK4(p0, 0, pa0); PK4(p0, 8, pa1); PK4(p1, 0, pa2); PK4(p1, 8, pa3);
#undef PK4
            if (__any(alpha < 1.f)) {
                if (hi == 0) wsl[r32] = alpha;
                asm volatile("s_waitcnt lgkmcnt(0)" ::: "memory");
#pragma unroll
                for (int r = 0; r < 16; ++r) { const float al = wsl[crow(r, hi)];
#pragma unroll
                    for (int d = 0; d < 4; ++d) o[d][r] *= al; }
            }
            if (bf == 0) pv_tile<0>(o, vb0, pa0, pa1, pa2, pa3); else pv_tile<1>(o, vb0, pa0, pa1, pa2, pa3);
        }
        if (TYPE == 1) {
            float mm = m_reg;
#pragma unroll
            for (int o_ = 16; o_ >= 1; o_ >>= 1) mm = fminf(mm, __shfl_xor(mm, o_));
            if (lane == 0) xm[(it2 & 1) * 8 + wid] = mm;
        }
        asm volatile("s_waitcnt vmcnt(0)" ::: "memory");
        __syncthreads();
        if (TYPE == 1 && it2 + 1 < ntiles) {
            const LAS float* xr = xm + (it2 & 1) * 8;
            const float mmin = fminf(fminf(fminf(xr[0], xr[1]), fminf(xr[2], xr[3])), fminf(fminf(xr[4], xr[5]), fminf(xr[6], xr[7])));
            const float bend = B_lds[(bf ^ 1) * 64 + 63];
            if (__builtin_amdgcn_readfirstlane(Bb + bend + 32.0f < mmin)) break;
        }
    }
    if (TYPE == 0 && mode != 0) {
        const int pi = (head * 17 + (qb - 16)) * 2 + (mode - 1);
        float* Op = (float*)(p.ws + WS_U) + (size_t)pi * (256 * 128) + (size_t)(wid * 32) * 128;
        float* ML = (float*)(p.ws + WS_U) + (size_t)272 * (256 * 128) + (size_t)pi * 512 + (wid * 32 + r32) * 2;
#pragma unroll
        for (int r = 0; r < 16; ++r)
#pragma unroll
            for (int d0 = 0; d0 < 4; ++d0) Op[crow(r, hi) * 128 + d0 * 32 + r32] = o[d0][r];
        if (hi == 0) { ML[0] = m_reg; ML[1] = l_reg; }
        __syncthreads();
        return;
    }
    if (hi == 0) wsl[32 + r32] = l_reg;
    asm volatile("s_waitcnt lgkmcnt(0)" ::: "memory");
    {
        LAS unsigned char* ot = lds + wid * 8704;
#pragma unroll
        for (int r = 0; r < 16; ++r) {
            const float rl = __builtin_amdgcn_rcpf(fmaxf(wsl[32 + crow(r, hi)], 1e-30f));
#pragma unroll
            for (int d0 = 0; d0 < 4; ++d0) {
                const unsigned w = cvt_pk_bf16(o[d0][r] * rl, 0.f);
                *(LAS bf16_t*)(ot + crow(r, hi) * 272 + (d0 * 32 + r32) * 2) = (bf16_t)(w & 0xffffu);
            }
        }
        asm volatile("s_waitcnt lgkmcnt(0)" ::: "memory");
        bf16_t* Cat = (bf16_t*)(p.ws + WS_CAT) + (TYPE == 0 ? 0 : 1024) + head * 128;
        const bf16_t* gate = (const bf16_t*)(p.ws + WS_Z) + 4096 + head * 128;
#pragma unroll 2
        for (int i = 0; i < 8; ++i) {
            const int id = i * 64 + lane, rr = id >> 4, ch = id & 15;
            const int orow = P0 + wid * 32 + rr;
            u32x4 w = *(const LAS u32x4*)(ot + rr * 272 + ch * 16);
            if (TYPE == 1) {
                const u32x4 gw = __builtin_nontemporal_load((const u32x4*)(gate + (size_t)orow * ZLD + ch * 8));
                float v[8], gv[8]; unpack8(w, v); unpack8(gw, gv);
#pragma unroll
                for (int e = 0; e < 8; ++e) v[e] *= __builtin_amdgcn_rcpf(1.0f + __builtin_amdgcn_exp2f(-LOG2E * gv[e]));
                w.x = cvt_pk_bf16(v[0], v[1]); w.y = cvt_pk_bf16(v[2], v[3]); w.z = cvt_pk_bf16(v[4], v[5]); w.w = cvt_pk_bf16(v[6], v[7]);
            }
            *(u32x4*)(Cat + (size_t)orow * DM + ch * 8) = w;
        }
    }
    __syncthreads();
#undef KMAX
#undef ADMA
}

__constant__ unsigned char MLA_ORDER[50] = {96, 160, 95, 159, 15, 94, 158, 93, 157, 14, 92, 156, 91, 155, 13, 90, 154, 89, 153, 12, 88, 152, 87, 151, 11, 86, 150, 85, 149, 10,
                                            84, 148, 83, 147, 9, 82, 146, 81, 145, 8, 80, 144, 7, 6, 5, 4, 3, 2, 1, 0};
__device__ __forceinline__ void phase_attn_combine(const Params& p) {
    const int gtid = blockIdx.x * NTHREADS + opaque_tid(), nthr = gridDim.x * NTHREADS;
    const float* Ob = (const float*)(p.ws + WS_U); const float* MLb = Ob + (size_t)272 * (256 * 128);
    bf16_t* Cat = (bf16_t*)(p.ws + WS_CAT);
    for (int task = gtid; task < 136 * 4096; task += nthr) {
        const int item = task >> 12, rc = task & 4095, row = rc >> 4, ch = rc & 15, head = item / 17, qb = 16 + item % 17;
        const float* O0 = Ob + (size_t)(item * 2) * (256 * 128) + row * 128 + ch * 8; const float* O1 = O0 + 256 * 128;
        const float m0 = MLb[(item * 2) * 512 + row * 2], l0 = MLb[(item * 2) * 512 + row * 2 + 1], m1 = MLb[(item * 2 + 1) * 512 + row * 2], l1 = MLb[(item * 2 + 1) * 512 + row * 2 + 1];
        const float m = fmaxf(m0, m1), w0 = __builtin_amdgcn_exp2f(m0 - m), w1 = __builtin_amdgcn_exp2f(m1 - m);
        const float inv = __builtin_amdgcn_rcpf(fmaxf(l0 * w0 + l1 * w1, 1e-30f));
        const f32x4 a0 = __builtin_nontemporal_load((const f32x4*)O0), a1 = __builtin_nontemporal_load((const f32x4*)(O0 + 4)), b0 = __builtin_nontemporal_load((const f32x4*)O1), b1 = __builtin_nontemporal_load((const f32x4*)(O1 + 4));
        const f32x4 x = (a0 * w0 + b0 * w1) * inv, y = (a1 * w0 + b1 * w1) * inv;
        u32x4 w; w.x = cvt_pk_bf16(x[0], x[1]); w.y = cvt_pk_bf16(x[2], x[3]); w.z = cvt_pk_bf16(y[0], y[1]); w.w = cvt_pk_bf16(y[2], y[3]);
        *(u32x4*)(Cat + (size_t)(qb * 256 + row) * DM + head * 128 + ch * 8) = w;
    }
}
__device__ __forceinline__ void phase_attn(const Params& p, int layer, LAS unsigned char* lds) {
    int* ctr = (int*)(p.ws + WS_CTR) + layer;
    LAS int* sitem = (LAS int*)(lds + LDS_BYTES - 16);
    for (;;) {
        if (opaque_tid() == 0) *sitem = atomicAdd(ctr, 1);
        __syncthreads();
        const int it = *sitem;
        __syncthreads();
        if (it >= 400 + 264) break;
        if (it < 264) attn_item<1>(p, layer, it & 7, 32 - (it >> 3), 0, lds);
        else { const int e = MLA_ORDER[(it - 264) >> 3]; attn_item<0>(p, layer, it & 7, e & 63, e >> 6, lds); }
    }
}

__device__ __forceinline__ void convert_gap(const Params& p, int layer, int nwg, int base, int per, LAS unsigned char* lds) {
    if (layer + 1 >= NLAYER) return;
    const int G = gridDim.x, c = blockIdx.x, rem = nwg % G;
    const int limit = base == GAP_PRE ? GAP_BASE6 : CT_LAYER;
    if (rem == 0) { __syncthreads(); convert_jobs<false>(p, (layer + 1) * CT_LAYER + base + c, (layer + 1) * CT_LAYER + limit, G, lds); return; }
    if (c < rem) return;
    const int slot = c - rem, nslots = G - rem;
    int j0 = base + slot * per, j1 = j0 + per;
    if (slot == nslots - 1 || j1 > limit) j1 = limit;
    if (j0 > limit) j0 = limit;
    __syncthreads();
    convert_jobs<false>(p, (layer + 1) * CT_LAYER + j0, (layer + 1) * CT_LAYER + j1, 1, lds);
}

#ifndef PHMASK0
#define PHMASK0 1
#endif
__device__ __forceinline__ void run_phase(const Params& pin, int ph, LAS unsigned char* lds, const XcdBarrier& xb) {
    Params p; p.ws = pin.ws; p.out = pin.out; p.ph_lo = pin.ph_lo; p.ph_hi = pin.ph_hi; asm volatile("" : "+s"(p.ws));
    {
        const float* const* tab = (const float* const*)(p.ws + WS_PTRS);
#pragma unroll
        for (int i = 0; i < 19; ++i) { const unsigned long long v = (unsigned long long)tab[i];
            const unsigned lo = __builtin_amdgcn_readfirstlane((unsigned)v), hi2 = __builtin_amdgcn_readfirstlane((unsigned)(v >> 32));
            p.in[i] = (const float*)(((unsigned long long)hi2 << 32) | lo); }
    }
    const int layer = (ph - 1) / 9, s = (ph - 1) % 9;
    unsigned char* wl = p.ws + WS_W + (size_t)layer * WL_SIZE;
    const float* cosT = (const float*)(p.ws + WS_COS); const float* sinT = (const float*)(p.ws + WS_SIN);
    float* ssqc = (float*)(p.ws + WS_SSQC);
    pg8::StaticOrder S;
#ifndef PHMASK
#define PHMASK 0x3ff
#endif
    if (!((PHMASK >> s) & 1)) return;
    switch (s) {
    case 0: {
        pg8::Gemm g{(const char*)(p.ws + WS_ABF), (const char*)(wl + WL_IN), DM, DM, 33, 21, 1 << 30, 0};
        S.init(33, 21, gridDim.x, blockIdx.x, 32);
        EpiIn E{(bf16_t*)(p.ws + WS_Z), ssqc, (bf16_t*)(p.ws + WS_KR), (float*)(p.ws + WS_LF), cosT, sinT, p.in[I_BF] + layer * 8};
        pg8::gemm_phase<EpiIn, pg8::StaticOrder>(lds, g, S, E);
        convert_gap(p, layer, 33 * 21, GAP_PRE, GAP_J1, lds);
    } break;
    case 1: {
        pg8::Gemm g{(const char*)(p.ws + WS_Z), (const char*)(wl + WL_QUP), ZLD, 512, 33, 14, 6, 1024};
        S.init(33, 14, gridDim.x, blockIdx.x, 8);
        EpiUp E{(bf16_t*)(p.ws + WS_QM), (bf16_t*)(p.ws + WS_KV), ssqc, cosT, sinT};
        pg8::gemm_phase<EpiUp, pg8::StaticOrder>(lds, g, S, E);
        __syncthreads();
        if ((int)blockIdx.x >= (int)gridDim.x - 8) phase_scan(p, (int)gridDim.x - 1 - (int)blockIdx.x, lds);
        phase_foxnorm(p, layer);
    } break;
    case 2: phase_attn(p, layer, lds); xcd_barrier(xb); phase_attn_combine(p); break;
    case 3: {
        pg8::Gemm g{(const char*)(p.ws + WS_CAT), (const char*)(wl + WL_OUT), DM, DM, 33, 8, 1 << 30, 0};
        pg8::SplitOrder SS; SS.init(32, 8, gridDim.x, blockIdx.x, 32, 16, 2);
        EpiF32 E{(bf16_t*)(p.ws + WS_MIX), (float*)(p.ws + WS_PART)};
        pg8::gemm_phase<EpiF32, pg8::SplitOrder>(lds, g, SS, E);
    } break;
    case 4: phase_resid(p, p.in[I_LNMIXPOST] + layer * DM, layer == 0, false, 16); break;
    case 5: {
        pg8::Gemm g{(const char*)(p.ws + WS_ABF), (const char*)(wl + WL_UP), DM, DM, 33, 44, 1 << 30, 0};
        S.init(33, 44, gridDim.x, blockIdx.x, 32);
        EpiU E{(bf16_t*)(p.ws + WS_U)};
        pg8::gemm_phase<EpiU, pg8::StaticOrder>(lds, g, S, E);
        convert_gap(p, layer, 33 * 44, GAP_BASE6, GAP_J6, lds);
    } break;
    case 6: phase_conv(p, layer); break;
    case 7: {
        pg8::Gemm g{(const char*)(p.ws + WS_G), (const char*)(wl + WL_DOWN), DFF, DFF, 33, 8, 1 << 30, 0};
        pg8::SplitOrder SS; SS.init(32, 8, gridDim.x, blockIdx.x, 88, 22, 4);
        EpiF32 E{(bf16_t*)(p.ws + WS_MIX), (float*)(p.ws + WS_PART)};
        pg8::gemm_phase<EpiF32, pg8::SplitOrder>(lds, g, SS, E);
    } break;
    case 8: phase_resid(p, p.in[I_LNFFNPOST] + layer * DM, false, layer == NLAYER - 1, 22); break;
    }
}

constexpr int NPHASE = 1 + 9 * NLAYER;

__global__ void __launch_bounds__(NTHREADS, 2) fwd_megakernel(Params p) {
    extern __shared__ __attribute__((aligned(16))) unsigned char smem[];
    LAS unsigned char* lds = (LAS unsigned char*)smem;
    cg::grid_group grid = cg::this_grid();
    volatile LAS unsigned* xst = (volatile LAS unsigned*)(lds + LDS_BYTES);
    if (threadIdx.x < 4) xst[threadIdx.x] = 0u;
    __syncthreads();
    const XcdBarrier xbar = xcd_barrier_post((unsigned*)(p.ws + WS_BAR), xst);
    int ph = p.ph_lo;
    if (ph == 0) {
        if (PHMASK0) phase_prep(p, lds);
        if (blockIdx.x == 0 && opaque_tid() == 0) {
#pragma unroll
            for (int i = 0; i < 19; ++i) ((const float**)(p.ws + WS_PTRS))[i] = p.in[i];
        }
        ++ph;
        if (p.ph_hi < 0) grid.sync();
        if (ph < p.ph_hi) xcd_barrier(xbar);
    }
    for (; ph < p.ph_hi; ++ph) {
        run_phase(p, ph, lds, xbar);
        if (ph + 1 < p.ph_hi) xcd_barrier(xbar);
    }
}

extern "C" void kernel_launch(void* const* d_in, const int* in_sizes, int n_in, void* d_out, int out_size, void* d_ws, size_t ws_size, hipStream_t stream) {
    static int grid = 0;
    if (grid == 0) {
        if (n_in != 19 || ws_size < WS_END) { fprintf(stderr, "kernel_launch: need 19 inputs and %zu bytes of workspace (got %d, %zu)\n", (size_t)WS_END, n_in, ws_size); grid = -1; return; }
        int dev = 0, cus = 0, per_cu = 0;
        hipGetDevice(&dev);
        hipDeviceGetAttribute(&cus, hipDeviceAttributeMultiprocessorCount, dev);
        if (hipFuncSetAttribute((const void*)fwd_megakernel, hipFuncAttributeMaxDynamicSharedMemorySize, LDS_TOTAL) != hipSuccess) { fprintf(stderr, "kernel_launch: hipFuncSetAttribute failed\n"); grid = -1; return; }
        hipOccupancyMaxActiveBlocksPerMultiprocessor(&per_cu, (const void*)fwd_megakernel, NTHREADS, LDS_TOTAL);
        if (per_cu < 1) { fprintf(stderr, "kernel_launch: occupancy query says %d blocks/CU\n", per_cu); per_cu = 1; }
        grid = cus * 1;
        (void)hipGetLastError();
    }
    if (grid < 0) return;
    Params p{};
    for (int i = 0; i < 19; ++i) p.in[i] = (const float*)d_in[i];
    p.out = (float*)d_out; p.ws = (unsigned char*)d_ws;
    if (hipMemsetAsync((char*)d_ws + WS_BAR, 0, 16384, stream) != hipSuccess) { fprintf(stderr, "kernel_launch: memset of the barrier words failed\n"); return; }
#if SINGLE_LAUNCH
    p.ph_lo = 0; p.ph_hi = NPHASE;
    void* args[] = {&p};
    hipError_t e = hipLaunchCooperativeKernel((const void*)fwd_megakernel, dim3(grid), dim3(NTHREADS), args, LDS_TOTAL, stream);
    if (e != hipSuccess) fprintf(stderr, "cooperative launch failed: %s (grid %d)\n", hipGetErrorString(e), grid);
#else
    for (int ph = 0; ph < NPHASE; ++ph) {
        p.ph_lo = ph; p.ph_hi = ph + 1;
        hipLaunchKernelGGL(fwd_megakernel, dim3(grid), dim3(NTHREADS), LDS_TOTAL, stream, p);
    }
#endif
}
```

```cpp
#include <hip/hip_runtime.h>
#include <hip/hip_cooperative_groups.h>
#include <cstdio>
#include <cstdint>
namespace cg = cooperative_groups;

#ifndef SINGLE_LAUNCH
#define SINGLE_LAUNCH 1
#endif

#define LAS __attribute__((address_space(3)))
typedef unsigned short bf16_t;
typedef short bf16x8 __attribute__((ext_vector_type(8)));
typedef short s16x4 __attribute__((ext_vector_type(4)));
typedef float f32x4 __attribute__((ext_vector_type(4)));
typedef float f32x16 __attribute__((ext_vector_type(16)));
typedef unsigned u32x4 __attribute__((ext_vector_type(4)));
typedef unsigned u32x2 __attribute__((ext_vector_type(2)));

constexpr int MROWS = 8448;
constexpr int PADR = 240, FRAME0 = 256, NMETA = 16, DM = 2048, NLAYER = 4;
constexpr int INC = 5192;
constexpr int ZLD = 5376;
constexpr int DFF = 5632, DFF2 = 11264;
constexpr float EPSN = 1e-6f, LOG2E = 1.4426950408889634f;
constexpr float QS_MLA = 0.07216878364870322f * LOG2E;
constexpr float QS_FOX = 0.08838834764831845f * LOG2E;
constexpr int NTHREADS = 512;
constexpr int LDS_BYTES = 131072;
constexpr int LDS_TOTAL = LDS_BYTES + 256;

constexpr size_t WL_IN = 0;
constexpr size_t WL_QUP = WL_IN + (size_t)ZLD * DM * 2;
constexpr size_t WL_KVUP = WL_QUP + (size_t)1536 * 512 * 2;
constexpr size_t WL_OUT = WL_KVUP + (size_t)2048 * 512 * 2;
constexpr size_t WL_UP = WL_OUT + (size_t)2048 * 2048 * 2;
constexpr size_t WL_DOWN = WL_UP + (size_t)DFF2 * DM * 2;
constexpr size_t WL_SIZE = WL_DOWN + (size_t)DM * DFF * 2;
constexpr size_t WS_W = 0;
constexpr size_t WS_H = WS_W + NLAYER * WL_SIZE;
constexpr size_t WS_ABF = WS_H + (size_t)MROWS * DM * 4;
constexpr size_t WS_Z = WS_ABF + (size_t)MROWS * DM * 2;
constexpr size_t WS_QM = WS_Z + (size_t)MROWS * ZLD * 2;
constexpr size_t WS_KV = WS_QM + (size_t)MROWS * 1536 * 2;
constexpr size_t WS_KR = WS_KV + (size_t)MROWS * 2048 * 2;
constexpr size_t WS_QF = WS_KR + (size_t)MROWS * 64 * 2;
constexpr size_t WS_KF = WS_QF + (size_t)MROWS * 1024 * 2;
constexpr size_t WS_CAT = WS_KF + (size_t)MROWS * 1024 * 2;
constexpr size_t WS_MIX = WS_CAT + (size_t)MROWS * DM * 2;
constexpr size_t WS_U = WS_MIX + (size_t)MROWS * DM * 4;
constexpr size_t WS_G = WS_U + (size_t)MROWS * DFF2 * 2;
constexpr size_t WS_SSQH = WS_G + (size_t)MROWS * DFF * 2;
constexpr size_t WS_SSQC = WS_SSQH + (size_t)MROWS * 4;
constexpr size_t WS_LF = WS_SSQC + (size_t)MROWS * 16 * 4;
constexpr size_t WS_BK = WS_LF + (size_t)MROWS * 8 * 4;
constexpr size_t WS_COS = WS_BK + (size_t)MROWS * 8 * 4;
constexpr size_t WS_SIN = WS_COS + (size_t)MROWS * 32 * 4;
constexpr size_t WS_CTR = WS_SIN + (size_t)MROWS * 32 * 4;
constexpr size_t WS_PART = WS_CTR + 256;
constexpr size_t WS_PTRS = WS_PART + (size_t)32 * 16 * DM * 4;
constexpr size_t WS_BAR = WS_PTRS + 256;
constexpr size_t WS_END = WS_BAR + 16384;

struct Params {
    const float* in[19];
    float* out;
    unsigned char* ws;
    int ph_lo, ph_hi;
};
enum { I_X = 0, I_META, I_LNMIXPRE, I_WIN, I_BF, I_GQL, I_GKVL, I_WQUP, I_WKVUP, I_GFQ, I_GFK, I_WOUT, I_LNMIXPOST, I_LNFFNPRE, I_WUP, I_WCONV, I_BCONV, I_WDOWN, I_LNFFNPOST };

__device__ __forceinline__ unsigned cvt_pk_bf16(float lo, float hi) { unsigned r; asm volatile("v_cvt_pk_bf16_f32 %0, %1, %2" : "=v"(r) : "v"(lo), "v"(hi)); return r; }
__device__ __forceinline__ float bf_lo(unsigned w) { return __uint_as_float(w << 16); }
__device__ __forceinline__ float bf_hi(unsigned w) { return __uint_as_float(w & 0xffff0000u); }
__device__ __forceinline__ void unpack8(const u32x4 w, float* v) {
    v[0] = bf_lo(w.x); v[1] = bf_hi(w.x); v[2] = bf_lo(w.y); v[3] = bf_hi(w.y); v[4] = bf_lo(w.z); v[5] = bf_hi(w.z); v[6] = bf_lo(w.w); v[7] = bf_hi(w.w);
}
__device__ __forceinline__ int opaque_tid() { int t = threadIdx.x; asm volatile("" : "+v"(t)); return t; }
__device__ __forceinline__ float wave_sum(float v) {
#pragma unroll
    for (int o = 32; o >= 1; o >>= 1) v += __shfl_xor(v, o);
    return v;
}


#define XB_TMO      128
#define XB_XCNT(j)  (256  + 64 * (j))
#define XB_XSUB(j)  (1280 + 64 * (j))
#define XB_XGEN(j)  (2304 + 64 * (j))
#define XB_TOP      3328
#define XB_TOPGEN   3392
#define XCD_BAR_WORDS 3456
#define XB_SPIN_CAP (1u << 18)
__device__ __forceinline__ unsigned xb_ld(unsigned* p)              { return __hip_atomic_load(p, __ATOMIC_RELAXED, __HIP_MEMORY_SCOPE_AGENT); }
__device__ __forceinline__ unsigned xb_add(unsigned* p, unsigned v) { return __hip_atomic_fetch_add(p, v, __ATOMIC_RELAXED, __HIP_MEMORY_SCOPE_AGENT); }
__device__ __forceinline__ unsigned xb_xcc_id() { return (unsigned)__builtin_amdgcn_s_getreg((3 << 11) | 20) & 0xFu; }
#define XB_SPIN(cond, bar) do { unsigned _sp = 0; while (cond) { __builtin_amdgcn_s_sleep(1); \
    if ((++_sp & 255u) == 0u) { if (xb_ld(&(bar)[XB_TMO])) break; if (_sp > XB_SPIN_CAP) { atomicAdd(&(bar)[XB_TMO], 1u); break; } } } } while (0)
struct XcdBarrier { unsigned* bar; unsigned x; volatile LAS unsigned* st; };
__device__ __forceinline__ XcdBarrier xcd_barrier_post(unsigned* bar, volatile LAS unsigned* st) {
    XcdBarrier b; b.bar = bar; b.x = xb_xcc_id(); b.st = st;
    if (threadIdx.x == 0) (void)xb_add(&bar[XB_XCNT(b.x)], 1u);
    return b;
}
__device__ __forceinline__ void xcd_barrier_complete(unsigned* bar, unsigned x, unsigned& nloc, unsigned& nx) {
    const unsigned G = gridDim.x * gridDim.y * gridDim.z;
    unsigned sum, cnt, mine, sp = 0u;
    for (;;) {
        sum = 0u; cnt = 0u; mine = 0u;
#pragma unroll
        for (unsigned j = 0; j < 16; ++j) { const unsigned c = xb_ld(&bar[XB_XCNT(j)]); sum += c; cnt += (c > 0u) ? 1u : 0u; mine = (j == x) ? c : mine; }
        if (sum == G) break;
        __builtin_amdgcn_s_sleep(1);
        if ((++sp & 255u) == 0u) { if (xb_ld(&bar[XB_TMO])) break; if (sp > XB_SPIN_CAP) { atomicAdd(&bar[XB_TMO], 1u); break; } }
    }
    nloc = mine > 0u ? mine : 1u; nx = cnt > 0u ? cnt : 1u;
}
__device__ __forceinline__ void xcd_barrier(const XcdBarrier& b) {
    asm volatile("s_waitcnt vmcnt(0)" ::: "memory");
    __syncthreads();
    if (threadIdx.x == 0) {
        unsigned* bar = b.bar;
        __builtin_amdgcn_s_waitcnt(0);
        unsigned nloc = b.st[0], nx = b.st[1];
        if (nloc == 0u) { xcd_barrier_complete(bar, b.x, nloc, nx); b.st[0] = nloc; b.st[1] = nx; }
        const unsigned old = xb_add(&bar[XB_XSUB(b.x)], 1u);
        const unsigned gen = old / nloc;
        if (old + 1u == (gen + 1u) * nloc) {
            __builtin_amdgcn_fence(__ATOMIC_RELEASE, "agent");
            asm volatile("s_waitcnt vmcnt(0)" ::: "memory");
            const unsigned og = xb_add(&bar[XB_TOP], 1u);
            const unsigned tg = og / nx;
            if (og + 1u == (tg + 1u) * nx) xb_add(&bar[XB_TOPGEN], 1u);
            else XB_SPIN(xb_ld(&bar[XB_TOPGEN]) == tg, bar);
            __builtin_amdgcn_fence(__ATOMIC_ACQUIRE, "agent");
            xb_add(&bar[XB_XGEN(b.x)], 1u);
            asm volatile("s_waitcnt vmcnt(0)" ::: "memory");
        } else {
            XB_SPIN(xb_ld(&bar[XB_XGEN(b.x)]) == gen, bar);
            __builtin_amdgcn_fence(__ATOMIC_ACQUIRE, "agent");
            asm volatile("s_waitcnt vmcnt(0)" ::: "memory");
        }
    }
    __syncthreads();
}

namespace pg8 {
constexpr int BM = 256, BK = 64, HALF = 128, HTB = HALF * BK * 2, STAGE_BYTES = 8 * HTB, NXCD = 8, WGM = 8;
__device__ __forceinline__ int lds_byte(int r, int c) { const int st = (r >> 4) * 2 + (c >> 5), rr = r & 15, cc = c & 31, ob = rr * 64 + cc * 2; return st * 1024 + (ob ^ (((ob >> 9) & 1) << 5)); }
__device__ __forceinline__ void stage_rc(int b, int& R, int& C) { const int st = b / 1024, sb = b % 1024, swz = sb ^ (((sb >> 9) & 1) << 5); R = (st >> 1) * 16 + swz / 64; C = (st & 1) * 32 + (swz % 64) / 2; }
__device__ __forceinline__ int perm32(int rho) { const int n = rho >> 4, i = rho & 15; return 8 * (i >> 2) + 4 * n + (i & 3); }
struct Unit { int pm, pn, k0t, nt, part; };
struct Gemm { const char* A; const char* Bt; int lda; int K; int nM, nN; int split; int a_off2; };
struct StaticOrder {
    int nM, nN, nwg, G, c, ntk;
    __device__ void init(int nM_, int nN_, int G_, int c_, int ntk_) { nM = nM_; nN = nN_; nwg = nM * nN; G = G_; c = c_; ntk = ntk_; }
    __device__ bool next(int i, Unit& u) const {
        const long L = (long)i * G + c; if (L >= nwg) return false;
        int wgid = (int)L; { const int q = nwg / NXCD, r = nwg % NXCD, xcd = wgid % NXCD, off = wgid / NXCD; wgid = (xcd < r ? xcd * (q + 1) : r * (q + 1) + (xcd - r) * q) + off; }
        const int nig = WGM * nN, gid = wgid / nig, fm = gid * WGM, gsz = (nM - fm) < WGM ? (nM - fm) : WGM;
        u.pm = fm + ((wgid % nig) % gsz); u.pn = (wgid % nig) / gsz; u.k0t = 0; u.nt = ntk; u.part = -1; return true;
    }
};
struct SplitOrder {
    StaticOrder so; int S, ntp;
    __device__ void init(int nM_, int nN_, int G_, int c_, int ntk_, int S_, int ntp_) { so.init(nM_, nN_, G_, c_, ntk_); S = S_; ntp = ntp_; }
    __device__ bool next(int i, Unit& u) const {
        if (so.next(i, u)) { u.pm += 1; return true; }
        const long L = (long)i * so.G + so.c - so.nwg; if (L >= (long)so.nN * S) return false;
        u.pm = 0; u.pn = (int)(L % so.nN); u.part = (int)(L / so.nN); u.k0t = u.part * ntp; u.nt = ntp; return true;
    }
};

template <class Epi, class Sched>
__device__ __forceinline__ void gemm_phase(LAS unsigned char* lds, const Gemm g, const Sched& S, const Epi& E) {
    const int tid = opaque_tid(), wid = __builtin_amdgcn_readfirstlane(tid >> 6), lane = tid & 63, wr = wid >> 2, wc = wid & 3, fr = lane & 15, fq = lane >> 4;
    const int K = g.K, lda = g.lda;
    unsigned voffA[2], voffB[2];
#pragma unroll
    for (int i = 0; i < 2; ++i) { int R, C; stage_rc(tid * 16 + i * 8192, R, C); const int Rb = Epi::PERM ? ((R & ~31) + perm32(R & 31)) : R;
        voffA[i] = (unsigned)(R * lda + C) * 2u; voffB[i] = (unsigned)(Rb * K + C) * 2u; }
    const size_t kstep = (size_t)(BK * 2);
    const size_t hstepA = (size_t)HALF * lda * 2, hstepB = (size_t)HALF * K * 2;
    const size_t tstepA = 2 * hstepA, tstepB = 2 * hstepB;
    const unsigned ldsw = (unsigned)wid * 1024u;
    const int aoff = lds_byte(wr * 64 + fr, fq * 8), boff = lds_byte(wc * 32 + fr, fq * 8);
#define PG8_SA(b, h) (((b) * 2 + (h)) * HTB)
#define PG8_SB(b, h) ((4 + (b) * 2 + (h)) * HTB)
#define PG8_STAGE(bufoff, gbase, voff) do { _Pragma("unroll") for (int _i = 0; _i < 2; ++_i) \
        __builtin_amdgcn_global_load_lds((const unsigned*)((const char*)(gbase) + (voff)[_i]), (LAS unsigned*)(lds + (bufoff) + ldsw + _i * 8192), 16, 0, 0); } while (0)
#define PG8_LDA(dst, b, h) do { _Pragma("unroll") for (int m = 0; m < 4; ++m) _Pragma("unroll") for (int k = 0; k < 2; ++k) dst[m][k] = *(const LAS bf16x8*)(lds + PG8_SA(b, h) + aoff + m * 2048 + k * 1024); } while (0)
#define PG8_LDB(dst, b, h) do { _Pragma("unroll") for (int n = 0; n < 2; ++n) _Pragma("unroll") for (int k = 0; k < 2; ++k) dst[n][k] = *(const LAS bf16x8*)(lds + PG8_SB(b, h) + boff + n * 2048 + k * 1024); } while (0)
#define PG8_MMA(ai, bj, At, Bt) do { __builtin_amdgcn_s_setprio(1); _Pragma("unroll") for (int m = 0; m < 4; ++m) _Pragma("unroll") for (int n = 0; n < 2; ++n) _Pragma("unroll") for (int k = 0; k < 2; ++k) \
        acc[ai][bj][m][n] = __builtin_amdgcn_mfma_f32_16x16x32_bf16(Bt[n][k], At[m][k], acc[ai][bj][m][n], 0, 0, 0); __builtin_amdgcn_s_setprio(0); } while (0)
#define PG8_WAIT_V(n) asm volatile("s_waitcnt vmcnt(" #n ")" ::: "memory")
#define PG8_WAIT_L(n) asm volatile("s_waitcnt lgkmcnt(" #n ")" ::: "memory")
#define PG8_BAR __builtin_amdgcn_s_barrier()
#define PG8_SCHED __builtin_amdgcn_sched_barrier(0)
#define PG8_APTR(u) (g.A + (size_t)(u).pm * tstepA + ((u).pn >= g.split ? (size_t)g.a_off2 : (size_t)0) + (size_t)(u).k0t * kstep)
#define PG8_BPTR(u) (g.Bt + (size_t)(u).pn * tstepB + (size_t)(u).k0t * kstep)
    Unit cur, nxt; int ui = 0;
    if (!S.next(0, cur)) return;
    f32x4 acc[2][2][4][2];
#pragma unroll
    for (int a = 0; a < 2; ++a)
#pragma unroll
        for (int b = 0; b < 2; ++b)
#pragma unroll
            for (int m = 0; m < 4; ++m)
#pragma unroll
                for (int n = 0; n < 2; ++n) acc[a][b][m][n] = (f32x4){0.f, 0.f, 0.f, 0.f};
    bf16x8 At[4][2], B0[2][2], B1[2][2];
    const char* cA = PG8_APTR(cur); const char* cB = PG8_BPTR(cur);
    PG8_STAGE(PG8_SB(0, 0), cB, voffB); PG8_STAGE(PG8_SA(0, 0), cA, voffA); PG8_STAGE(PG8_SB(0, 1), cB + hstepB, voffB); PG8_STAGE(PG8_SA(0, 1), cA + hstepA, voffA);
    if (wr == 1) PG8_BAR;
    PG8_WAIT_V(4); PG8_BAR;
    PG8_STAGE(PG8_SB(1, 0), cB + kstep, voffB); PG8_STAGE(PG8_SA(1, 0), cA + kstep, voffA); PG8_STAGE(PG8_SB(1, 1), cB + hstepB + kstep, voffB);
    PG8_WAIT_V(6); PG8_BAR;
    for (;;) {
        const bool has_next = S.next(ui + 1, nxt);
        const char* nA = has_next ? PG8_APTR(nxt) : cA; const char* nB = has_next ? PG8_BPTR(nxt) : cB;
        const int nt = cur.nt;
        for (int t = 0; t < nt; t += 2) {
            const bool last = (t == nt - 2);
            const char* a1 = cA + (size_t)(t + 1) * kstep;
            const char* a2 = last ? nA : cA + (size_t)(t + 2) * kstep; const char* b2 = last ? nB : cB + (size_t)(t + 2) * kstep;
            const char* a3 = a2 + kstep; const char* b3 = b2 + kstep;
            PG8_LDB(B0, 0, 0); PG8_SCHED; PG8_LDA(At, 0, 0); PG8_STAGE(PG8_SA(1, 1), a1 + hstepA, voffA);
            PG8_WAIT_L(8); PG8_BAR; PG8_WAIT_L(0); PG8_MMA(0, 0, At, B0); PG8_BAR; PG8_SCHED;
            PG8_LDB(B1, 0, 1); PG8_STAGE(PG8_SB(0, 0), b2, voffB);
            PG8_BAR; PG8_WAIT_L(0); PG8_MMA(0, 1, At, B1); PG8_BAR;
            PG8_LDA(At, 0, 1); PG8_STAGE(PG8_SA(0, 0), a2, voffA);
            PG8_BAR; PG8_WAIT_L(0); PG8_MMA(1, 0, At, B0); PG8_BAR; PG8_SCHED;
            PG8_STAGE(PG8_SB(0, 1), b2 + hstepB, voffB);
            PG8_WAIT_V(6); PG8_BAR; PG8_MMA(1, 1, At, B1); PG8_BAR;
            PG8_LDB(B0, 1, 0); PG8_SCHED; PG8_LDA(At, 1, 0); PG8_STAGE(PG8_SA(0, 1), a2 + hstepA, voffA);
            PG8_WAIT_L(8); PG8_BAR; PG8_WAIT_L(0); PG8_MMA(0, 0, At, B0); PG8_BAR; PG8_SCHED;
            PG8_LDB(B1, 1, 1); PG8_STAGE(PG8_SB(1, 0), b3, voffB);
            PG8_BAR; PG8_WAIT_L(0); PG8_MMA(0, 1, At, B1); PG8_BAR;
            PG8_LDA(At, 1, 1); PG8_STAGE(PG8_SA(1, 0), a3, voffA);
            PG8_BAR; PG8_WAIT_L(0); PG8_MMA(1, 0, At, B0); PG8_BAR; PG8_SCHED;
            PG8_STAGE(PG8_SB(1, 1), b3 + hstepB, voffB);
            PG8_WAIT_V(6); PG8_BAR; PG8_MMA(1, 1, At, B1); PG8_BAR;
        }
        E(acc, cur, wr, wc, fr, fq);
        if (!has_next) break;
#pragma unroll
        for (int a = 0; a < 2; ++a)
#pragma unroll
            for (int b = 0; b < 2; ++b)
#pragma unroll
                for (int m = 0; m < 4; ++m)
#pragma unroll
                    for (int n = 0; n < 2; ++n) acc[a][b][m][n] = (f32x4){0.f, 0.f, 0.f, 0.f};
        cur = nxt; cA = nA; cB = nB; ++ui;
    }
    PG8_WAIT_V(0);
    if (wr == 0) PG8_BAR;
    PG8_BAR;
#undef PG8_SA
#undef PG8_SB
#undef PG8_STAGE
#undef PG8_LDA
#undef PG8_LDB
#undef PG8_MMA
#undef PG8_WAIT_V
#undef PG8_WAIT_L
#undef PG8_BAR
#undef PG8_SCHED
#undef PG8_APTR
#undef PG8_BPTR
}
}

typedef f32x4 AccT[2][2][4][2];

__device__ __forceinline__ u32x4 pack8s(f32x4 a, f32x4 b, float s) {
    u32x4 w; w.x = cvt_pk_bf16(a[0] * s, a[1] * s); w.y = cvt_pk_bf16(a[2] * s, a[3] * s); w.z = cvt_pk_bf16(b[0] * s, b[1] * s); w.w = cvt_pk_bf16(b[2] * s, b[3] * s); return w;
}

struct EpiIn {
    static constexpr bool PERM = true;
    bf16_t* Z; float* ssqp; bf16_t* Kr; float* lf; const float* cosT; const float* sinT; const float* bfg;
    __device__ __forceinline__ void operator()(const AccT& acc, const pg8::Unit& u, int wr, int wc, int fr, int fq) const {
        const int row0 = u.pm * 256 + wr * 64 + fr;
#pragma unroll
        for (int ai = 0; ai < 2; ++ai)
#pragma unroll
            for (int m = 0; m < 4; ++m) {
                const int row = row0 + ai * 128 + m * 16;
                const float rs = 1.0f;
                if (u.pn < 20) {
                    float ss = 0.f;
#pragma unroll
                    for (int bj = 0; bj < 2; ++bj) {
                        const f32x4 a = acc[ai][bj][m][0], b = acc[ai][bj][m][1];
                        *(u32x4*)(Z + (size_t)row * ZLD + u.pn * 256 + bj * 128 + wc * 32 + 8 * fq) = pack8s(a, b, rs);
#pragma unroll
                        for (int j = 0; j < 4; ++j) ss += a[j] * a[j] + b[j] * b[j];
                    }
                    if (u.pn < 4) {
                        ss *= rs * rs;
                        ss += __shfl_xor(ss, 16); ss += __shfl_xor(ss, 32);
                        if (fq == 0) ssqp[row * 16 + u.pn * 4 + wc] = ss;
                    }
                } else {
                    if (wc == 0) {
                        const f32x4 c0 = *(const f32x4*)(cosT + row * 32 + 8 * fq), c1 = *(const f32x4*)(cosT + row * 32 + 8 * fq + 4);
                        const f32x4 s0 = *(const f32x4*)(sinT + row * 32 + 8 * fq), s1 = *(const f32x4*)(sinT + row * 32 + 8 * fq + 4);
                        const f32x4 x1a = acc[ai][0][m][0] * rs, x1b = acc[ai][0][m][1] * rs, x2a = acc[ai][1][m][0] * rs, x2b = acc[ai][1][m][1] * rs;
                        const f32x4 y1a = x1a * c0 - x2a * s0, y1b = x1b * c1 - x2b * s1, y2a = x2a * c0 + x1a * s0, y2b = x2b * c1 + x1b * s1;
                        *(u32x4*)(Kr + (size_t)row * 64 + 8 * fq) = pack8s(y1a, y1b, 1.0f);
                        *(u32x4*)(Kr + (size_t)row * 64 + 32 + 8 * fq) = pack8s(y2a, y2b, 1.0f);
                    } else if (wc == 1 && fq == 0) {
#pragma unroll
                        for (int n = 0; n < 2; ++n)
#pragma unroll
                            for (int j = 0; j < 4; ++j) {
                                const float x = acc[ai][0][m][n][j] * rs + bfg[4 * n + j];
                                lf[(4 * n + j) * MROWS + row] = fminf(x, 0.f) - log1pf(__expf(-fabsf(x)));
                            }
                    }
                }
            }
    }
};

struct EpiUp {
    static constexpr bool PERM = true;
    bf16_t* Qm; bf16_t* KV; const float* ssqp; const float* cosT; const float* sinT;
    __device__ __forceinline__ float ssq8(int row, int which) const { const f32x4 a = *(const f32x4*)(ssqp + row * 16 + which * 8), b = *(const f32x4*)(ssqp + row * 16 + which * 8 + 4); return ((a[0] + a[1]) + (a[2] + a[3])) + ((b[0] + b[1]) + (b[2] + b[3])); }
    __device__ __forceinline__ void operator()(const AccT& acc, const pg8::Unit& u, int wr, int wc, int fr, int fq) const {
        const int row0 = u.pm * 256 + wr * 64 + fr;
#pragma unroll
        for (int ai = 0; ai < 2; ++ai)
#pragma unroll
            for (int m = 0; m < 4; ++m) {
                const int row = row0 + ai * 128 + m * 16;
                if (u.pn < 4) {
                    const float rs = rsqrtf(ssq8(row, 0) * (1.0f / 512) + EPSN) * QS_MLA;
#pragma unroll
                    for (int bj = 0; bj < 2; ++bj)
                        *(u32x4*)(Qm + (size_t)row * 1536 + (2 * u.pn + bj) * 192 + wc * 32 + 8 * fq) = pack8s(acc[ai][bj][m][0], acc[ai][bj][m][1], rs);
                } else if (u.pn < 6) {
                    const float rs = rsqrtf(ssq8(row, 0) * (1.0f / 512) + EPSN) * QS_MLA;
                    const int head = 4 * (u.pn - 4) + wc;
                    const f32x4 c0 = *(const f32x4*)(cosT + row * 32 + 8 * fq), c1 = *(const f32x4*)(cosT + row * 32 + 8 * fq + 4);
                    const f32x4 s0 = *(const f32x4*)(sinT + row * 32 + 8 * fq), s1 = *(const f32x4*)(sinT + row * 32 + 8 * fq + 4);
                    const f32x4 x1a = acc[ai][0][m][0] * rs, x1b = acc[ai][0][m][1] * rs, x2a = acc[ai][1][m][0] * rs, x2b = acc[ai][1][m][1] * rs;
                    const f32x4 y1a = x1a * c0 - x2a * s0, y1b = x1b * c1 - x2b * s1, y2a = x2a * c0 + x1a * s0, y2b = x2b * c1 + x1b * s1;
                    *(u32x4*)(Qm + (size_t)row * 1536 + head * 192 + 128 + 8 * fq) = pack8s(y1a, y1b, 1.0f);
                    *(u32x4*)(Qm + (size_t)row * 1536 + head * 192 + 160 + 8 * fq) = pack8s(y2a, y2b, 1.0f);
                } else {
                    const float rs = rsqrtf(ssq8(row, 1) * (1.0f / 512) + EPSN);
#pragma unroll
                    for (int bj = 0; bj < 2; ++bj)
                        *(u32x4*)(KV + (size_t)row * 2048 + (u.pn - 6) * 256 + bj * 128 + wc * 32 + 8 * fq) = pack8s(acc[ai][bj][m][0], acc[ai][bj][m][1], rs);
                }
            }
    }
};

struct EpiF32 {
    static constexpr bool PERM = true;
    bf16_t* C; float* Part;
    __device__ __forceinline__ void operator()(const AccT& acc, const pg8::Unit& u, int wr, int wc, int fr, int fq) const {
        const int row0 = u.pm * 256 + wr * 64 + fr, col0 = u.pn * 256 + wc * 32 + 8 * fq;
        if (u.part >= 0) {
            if (wr == 1) { float* rowp = Part + (size_t)(u.part * 16 + fr) * DM + col0;
#pragma unroll
                for (int bj = 0; bj < 2; ++bj)
#pragma unroll
                    for (int n = 0; n < 2; ++n) *(f32x4*)(rowp + bj * 128 + n * 4) = acc[1][bj][3][n]; }
            return;
        }
#pragma unroll
        for (int ai = 0; ai < 2; ++ai)
#pragma unroll
            for (int m = 0; m < 4; ++m) { bf16_t* rowp = C + (size_t)(row0 + ai * 128 + m * 16) * DM + col0;
#pragma unroll
                for (int bj = 0; bj < 2; ++bj) *(u32x4*)(rowp + bj * 128) = pack8s(acc[ai][bj][m][0], acc[ai][bj][m][1], 1.0f); }
    }
};

struct EpiU {
    static constexpr bool PERM = true;
    bf16_t* U;
    __device__ __forceinline__ void operator()(const AccT& acc, const pg8::Unit& u, int wr, int wc, int fr, int fq) const {
        const int row0 = u.pm * 256 + wr * 64 + fr;
#pragma unroll
        for (int ai = 0; ai < 2; ++ai)
#pragma unroll
            for (int m = 0; m < 4; ++m) {
                const int row = row0 + ai * 128 + m * 16;
                const float rs = 1.0f;
#pragma unroll
                for (int bj = 0; bj < 2; ++bj)
                    *(u32x4*)(U + (size_t)row * DFF2 + u.pn * 256 + bj * 128 + wc * 32 + 8 * fq) = pack8s(acc[ai][bj][m][0], acc[ai][bj][m][1], rs);
            }
    }
};

__device__ __forceinline__ int srccol_in(int n) {
    if (n < 1024) return n;
    if (n < 5120) return n + 64;
    const int c = n - 5120;
    if (c < 32) return 1024 + c;
    if (c < 40) return 5184 + (c - 32);
    if (c >= 128 && c < 160) return 1056 + (c - 128);
    return -1;
}
__device__ __forceinline__ int srccol_qup(int n) {
    if (n < 1024) return (n >> 7) * 192 + (n & 127);
    const int r = n - 1024, t = r >> 8, c = r & 255, half = c >> 7, hh = (c & 127) >> 5, i = c & 31;
    return (4 * t + hh) * 192 + 128 + half * 32 + i;
}
constexpr int CT_IN = 16 * 42, CT_QUP = 4 * 12, CT_KVUP = 4 * 16, CT_OUT = 16 * 16, CT_UP = 16 * 88, CT_DOWN = 44 * 16;
constexpr int CT_LAYER = CT_IN + CT_QUP + CT_KVUP + CT_OUT + CT_UP + CT_DOWN;

struct CvtJob { const float* W; const float* gain; bf16_t* dst; int K, Nsrc, mat, k0, n0; };
__device__ __forceinline__ CvtJob cvt_decode(const Params& p, int job) {
    CvtJob j; j.gain = nullptr;
    const int layer = job / CT_LAYER; int r = job % CT_LAYER;
    unsigned char* wl = p.ws + WS_W + (size_t)layer * WL_SIZE;
    if (r < CT_IN) { j.mat = 0; j.K = 2048; j.Nsrc = INC; j.W = p.in[I_WIN] + (size_t)layer * 2048 * INC; j.gain = p.in[I_LNMIXPRE] + layer * 2048; j.dst = (bf16_t*)(wl + WL_IN); }
    else if ((r -= CT_IN) < CT_QUP) { j.mat = 1; j.K = 512; j.Nsrc = 1536; j.W = p.in[I_WQUP] + (size_t)layer * 512 * 1536; j.gain = p.in[I_GQL] + layer * 512; j.dst = (bf16_t*)(wl + WL_QUP); }
    else if ((r -= CT_QUP) < CT_KVUP) { j.mat = 2; j.K = 512; j.Nsrc = 2048; j.W = p.in[I_WKVUP] + (size_t)layer * 512 * 2048; j.gain = p.in[I_GKVL] + layer * 512; j.dst = (bf16_t*)(wl + WL_KVUP); }
    else if ((r -= CT_KVUP) < CT_OUT) { j.mat = 3; j.K = 2048; j.Nsrc = 2048; j.W = p.in[I_WOUT] + (size_t)layer * 2048 * 2048; j.dst = (bf16_t*)(wl + WL_OUT); }
    else if ((r -= CT_OUT) < CT_UP) { j.mat = 4; j.K = 2048; j.Nsrc = DFF2; j.W = p.in[I_WUP] + (size_t)layer * 2048 * DFF2; j.gain = p.in[I_LNFFNPRE] + layer * 2048; j.dst = (bf16_t*)(wl + WL_UP); }
    else { r -= CT_UP; j.mat = 5; j.K = DFF; j.Nsrc = 2048; j.W = p.in[I_WDOWN] + (size_t)layer * DFF * 2048; j.dst = (bf16_t*)(wl + WL_DOWN); }
    const int nKt = j.K / 128, kt = r % nKt, ntile = r / nKt; j.k0 = kt * 128; j.n0 = ntile * 128;
    return j;
}
__device__ __forceinline__ void cvt_load(const CvtJob& j, int tid, f32x4 (&v)[8], float (&gk)[8]) {
    const int nq = tid & 31, kk = tid >> 5, nd = j.n0 + 4 * nq;
    const int sc = j.mat == 0 ? srccol_in(nd) : (j.mat == 1 ? srccol_qup(nd) : nd);
#pragma unroll
    for (int i = 0; i < 8; ++i) {
        const int k = kk + 16 * i;
        v[i] = (f32x4){0.f, 0.f, 0.f, 0.f};
        if (sc >= 0) v[i] = __builtin_nontemporal_load((const f32x4*)(j.W + (size_t)(j.k0 + k) * j.Nsrc + sc));
        gk[i] = j.gain ? j.gain[j.k0 + k] : 1.0f;
    }
}
__device__ __forceinline__ void cvt_store(const CvtJob& j, int tid, const f32x4 (&v)[8], const float (&gk)[8], LAS unsigned char* lds) {
    LAS bf16_t* T = (LAS bf16_t*)lds;
    {
        const int nq = tid & 31, kk = tid >> 5;
#pragma unroll
        for (int i = 0; i < 8; ++i) {
            const int k = kk + 16 * i;
#pragma unroll
            for (int jj = 0; jj < 4; ++jj) { const unsigned w = cvt_pk_bf16(v[i][jj] * gk[i], 0.f); T[(jj * 32 + nq) * 130 + k] = (bf16_t)(w & 0xffffu); }
        }
    }
    __syncthreads();
    {
        const int n = tid >> 2, kc = tid & 3, rs_ = (n & 3) * 32 + (n >> 2);
        const LAS unsigned* T32 = (const LAS unsigned*)lds;
        bf16_t* d = j.dst + (size_t)(j.n0 + n) * j.K + j.k0 + kc * 32;
#pragma unroll
        for (int h2 = 0; h2 < 4; ++h2) {
            u32x4 w;
            w.x = T32[rs_ * 65 + kc * 16 + h2 * 4 + 0]; w.y = T32[rs_ * 65 + kc * 16 + h2 * 4 + 1]; w.z = T32[rs_ * 65 + kc * 16 + h2 * 4 + 2]; w.w = T32[rs_ * 65 + kc * 16 + h2 * 4 + 3];
            *(u32x4*)(d + h2 * 8) = w;
        }
    }
    __syncthreads();
}
constexpr int GAP_PRE = 1300, GAP_J1 = 11, GAP_J6 = 13, GAP_BASE6 = GAP_PRE + 75 * GAP_J1;
constexpr int PREP_JOBS = CT_LAYER + (NLAYER - 1) * GAP_PRE;
template <bool PREPMAP> __device__ __forceinline__ int cvt_map(int q) {
    if (!PREPMAP || q < CT_LAYER) return q;
    const int r = q - CT_LAYER; return (1 + r / GAP_PRE) * CT_LAYER + r % GAP_PRE;
}
template <bool PREPMAP>
__device__ __forceinline__ void convert_jobs(const Params& p, int job0, int job_end, int stride, LAS unsigned char* lds) {
    if (job0 >= job_end) return;
    const int tid = opaque_tid();
    int job = job0;
    CvtJob cur = cvt_decode(p, cvt_map<PREPMAP>(job));
    f32x4 v[8]; float gk[8];
    cvt_load(cur, tid, v, gk);
    for (;;) {
        const int nj = job + stride; const bool more = nj < job_end;
        CvtJob nxt = cur; f32x4 v2[8]; float gk2[8];
        if (more) { nxt = cvt_decode(p, cvt_map<PREPMAP>(nj)); cvt_load(nxt, tid, v2, gk2); }
        cvt_store(cur, tid, v, gk, lds);
        if (!more) break;
#pragma unroll
        for (int i = 0; i < 8; ++i) { v[i] = v2[i]; gk[i] = gk2[i]; }
        cur = nxt; job = nj;
    }
}

__device__ __forceinline__ void phase_prep(const Params& p, LAS unsigned char* lds) {
    const int tid = opaque_tid(), G = gridDim.x, b = blockIdx.x;
    const int gtid = b * NTHREADS + tid, nthr = G * NTHREADS;
    if (gtid < 64) ((int*)(p.ws + WS_CTR))[gtid] = 0;
    { float* cosT = (float*)(p.ws + WS_COS); float* sinT = (float*)(p.ws + WS_SIN);
      for (int i = gtid; i < MROWS * 32; i += nthr) {
          const int row_ = i >> 5, f = i & 31, pos = row_ < PADR ? 0 : row_ - PADR;
          const float invf = exp2f(-(float)f * (13.287712379549449f / 32.0f));
          const float ang = (float)pos * invf;
          const double rev = (double)ang * 0.15915494309189535;
          const float fr = (float)(rev - floor(rev));
          cosT[i] = __builtin_amdgcn_cosf(fr); sinT[i] = __builtin_amdgcn_sinf(fr);
      } }
    { const int lane = tid & 63, gw = gtid >> 6, nw = nthr >> 6;
      bf16_t* abf = (bf16_t*)(p.ws + WS_ABF);
      for (int row = gw; row < MROWS; row += nw) {
          const float* src = row < PADR ? nullptr : (row < FRAME0 ? p.in[I_META] + (size_t)(row - PADR) * DM : p.in[I_X] + (size_t)(row - FRAME0) * DM);
          float ss = 0.f; f32x4 v[8];
#pragma unroll
          for (int i = 0; i < 8; ++i) {
              const int c = lane * 4 + 256 * i;
              v[i] = (f32x4){0.f, 0.f, 0.f, 0.f};
              if (src) v[i] = __builtin_nontemporal_load((const f32x4*)(src + c));
              ss += v[i][0] * v[i][0] + v[i][1] * v[i][1] + v[i][2] * v[i][2] + v[i][3] * v[i][3];
          }
          ss = wave_sum(ss);
          const float rs = rsqrtf(ss * (1.0f / DM) + EPSN);
#pragma unroll
          for (int i = 0; i < 8; ++i) {
              u32x2 w; w.x = cvt_pk_bf16(v[i][0] * rs, v[i][1] * rs); w.y = cvt_pk_bf16(v[i][2] * rs, v[i][3] * rs);
              *(u32x2*)(abf + (size_t)row * DM + lane * 4 + 256 * i) = w;
          }
      } }
    convert_jobs<true>(p, b, PREP_JOBS, G, lds);
}

__device__ __forceinline__ void phase_resid(const Params& p, const float* g, bool first, bool last, int nsplit) {
    const int tid = opaque_tid(), lane = tid & 63, gw = (blockIdx.x * NTHREADS + tid) >> 6, nw = (gridDim.x * NTHREADS) >> 6;
    float* h = (float*)(p.ws + WS_H); bf16_t* abf = (bf16_t*)(p.ws + WS_ABF);
    const bf16_t* mix = (const bf16_t*)(p.ws + WS_MIX);
    const float* part = (const float*)(p.ws + WS_PART);
    f32x4 gv[8];
#pragma unroll
    for (int i = 0; i < 8; ++i) gv[i] = *(const f32x4*)(g + lane * 4 + 256 * i);
#define HROW(r) (first ? ((r) < FRAME0 ? p.in[I_META] + (size_t)((r) - PADR) * DM : p.in[I_X] + (size_t)((r) - FRAME0) * DM) : (const float*)h + (size_t)(r) * DM)
#define RESID_ROW(row, MV, HV) do { \
        float ss = 0.f; \
        _Pragma("unroll") for (int i = 0; i < 8; ++i) ss += MV[i][0] * MV[i][0] + MV[i][1] * MV[i][1] + MV[i][2] * MV[i][2] + MV[i][3] * MV[i][3]; \
        ss = wave_sum(ss); \
        const float rs = rsqrtf(ss * (1.0f / DM) + EPSN); \
        float s2 = 0.f; \
        _Pragma("unroll") for (int i = 0; i < 8; ++i) { \
            const int c = lane * 4 + 256 * i; \
            const f32x4 o = HV[i] + MV[i] * rs * gv[i]; \
            if (!last) *(f32x4*)(h + (size_t)(row) * DM + c) = o; \
            HV[i] = o; \
            s2 += o[0] * o[0] + o[1] * o[1] + o[2] * o[2] + o[3] * o[3]; \
            if (last && (row) >= FRAME0) *(f32x4*)(p.out + (size_t)((row) - FRAME0) * DM + c) = o; \
        } \
        if (last) break; \
        s2 = wave_sum(s2); \
        const float rs2 = rsqrtf(s2 * (1.0f / DM) + EPSN);            \
        _Pragma("unroll") for (int i = 0; i < 8; ++i) { \
            u32x2 w; w.x = cvt_pk_bf16(HV[i][0] * rs2, HV[i][1] * rs2); w.y = cvt_pk_bf16(HV[i][2] * rs2, HV[i][3] * rs2); \
            *(u32x2*)(abf + (size_t)(row) * DM + lane * 4 + 256 * i) = w; \
        } } while (0)
    if (gw < 16) {
        const int row = PADR + gw;
        f32x4 mv[8], hv[8];
#pragma unroll
        for (int i = 0; i < 8; ++i) { mv[i] = (f32x4){0.f, 0.f, 0.f, 0.f}; hv[i] = *(const f32x4*)(HROW(row) + lane * 4 + 256 * i); }
        for (int sp = 0; sp < nsplit; ++sp) {
#pragma unroll
            for (int i = 0; i < 8; ++i) mv[i] += *(const f32x4*)(part + (size_t)(sp * 16 + gw) * DM + lane * 4 + 256 * i);
        }
        RESID_ROW(row, mv, hv);
    }
    int row = FRAME0 + (nw - 1 - gw);
    if (row < MROWS) {
        f32x4 mv[8], hv[8];
#pragma unroll
        for (int i = 0; i < 8; ++i) { const u32x2 mw = __builtin_nontemporal_load((const u32x2*)(mix + (size_t)row * DM + lane * 4 + 256 * i)); mv[i] = (f32x4){bf_lo(mw.x), bf_hi(mw.x), bf_lo(mw.y), bf_hi(mw.y)}; hv[i] = *(const f32x4*)(HROW(row) + lane * 4 + 256 * i); }
        for (;;) {
            const int nrow = row + nw; const bool more = nrow < MROWS;
            f32x4 mv2[8], hv2[8];
            if (more) {
#pragma unroll
                for (int i = 0; i < 8; ++i) { const u32x2 mw = __builtin_nontemporal_load((const u32x2*)(mix + (size_t)nrow * DM + lane * 4 + 256 * i)); mv2[i] = (f32x4){bf_lo(mw.x), bf_hi(mw.x), bf_lo(mw.y), bf_hi(mw.y)}; hv2[i] = *(const f32x4*)(HROW(nrow) + lane * 4 + 256 * i); }
            }
            RESID_ROW(row, mv, hv);
            if (!more) break;
#pragma unroll
            for (int i = 0; i < 8; ++i) { mv[i] = mv2[i]; hv[i] = hv2[i]; }
            row = nrow;
        }
    }
#undef RESID_ROW
#undef HROW
}

__device__ __forceinline__ void foxnorm_half(const u32x4 a, const u32x4 b2, const float* gg, float qs, bf16_t* dst) {
    float v[16]; unpack8(a, v); unpack8(b2, v + 8);
    float ss = 0.f;
#pragma unroll
    for (int j = 0; j < 16; ++j) ss += v[j] * v[j];
    ss += __shfl_xor(ss, 1); ss += __shfl_xor(ss, 2); ss += __shfl_xor(ss, 4);
    const float rs = rsqrtf(ss * (1.0f / 128) + EPSN) * qs;
    u32x4 o0, o1;
    o0.x = cvt_pk_bf16(v[0] * rs * gg[0], v[1] * rs * gg[1]); o0.y = cvt_pk_bf16(v[2] * rs * gg[2], v[3] * rs * gg[3]);
    o0.z = cvt_pk_bf16(v[4] * rs * gg[4], v[5] * rs * gg[5]); o0.w = cvt_pk_bf16(v[6] * rs * gg[6], v[7] * rs * gg[7]);
    o1.x = cvt_pk_bf16(v[8] * rs * gg[8], v[9] * rs * gg[9]); o1.y = cvt_pk_bf16(v[10] * rs * gg[10], v[11] * rs * gg[11]);
    o1.z = cvt_pk_bf16(v[12] * rs * gg[12], v[13] * rs * gg[13]); o1.w = cvt_pk_bf16(v[14] * rs * gg[14], v[15] * rs * gg[15]);
    *(u32x4*)dst = o0; *(u32x4*)(dst + 8) = o1;
}
__device__ __forceinline__ void phase_foxnorm(const Params& p, int layer) {
    const int tid = opaque_tid(), lane = tid & 63, gw = (blockIdx.x * NTHREADS + tid) >> 6, nw = (gridDim.x * NTHREADS) >> 6;
    const bf16_t* Z = (const bf16_t*)(p.ws + WS_Z); bf16_t* Qf = (bf16_t*)(p.ws + WS_QF); bf16_t* Kf = (bf16_t*)(p.ws + WS_KF);
    const int d0 = (lane & 7) * 16;
    float gq[16], gk[16];
#pragma unroll
    for (int j = 0; j < 16; j += 4) { *(f32x4*)&gq[j] = *(const f32x4*)(p.in[I_GFQ] + layer * 128 + d0 + j); *(f32x4*)&gk[j] = *(const f32x4*)(p.in[I_GFK] + layer * 128 + d0 + j); }
    int row = gw;
    if (row >= MROWS) return;
    const bf16_t* src = Z + (size_t)row * ZLD + 1024 + lane * 16;
    u32x4 qa = __builtin_nontemporal_load((const u32x4*)src), qb = __builtin_nontemporal_load((const u32x4*)(src + 8)), ka = __builtin_nontemporal_load((const u32x4*)(src + 1024)), kb2 = __builtin_nontemporal_load((const u32x4*)(src + 1032));
    for (;;) {
        const int nrow = row + nw; const bool more = nrow < MROWS;
        u32x4 qa2, qb2, ka2, kb3;
        if (more) { const bf16_t* s2 = Z + (size_t)nrow * ZLD + 1024 + lane * 16; qa2 = __builtin_nontemporal_load((const u32x4*)s2); qb2 = __builtin_nontemporal_load((const u32x4*)(s2 + 8)); ka2 = __builtin_nontemporal_load((const u32x4*)(s2 + 1024)); kb3 = __builtin_nontemporal_load((const u32x4*)(s2 + 1032)); }
        foxnorm_half(qa, qb, gq, QS_FOX, Qf + (size_t)row * 1024 + lane * 16);
        foxnorm_half(ka, kb2, gk, 1.0f, Kf + (size_t)row * 1024 + lane * 16);
        if (!more) break;
        qa = qa2; qb = qb2; ka = ka2; kb2 = kb3; row = nrow;
    }
}

__device__ __forceinline__ void phase_scan(const Params& p, int head, LAS unsigned char* lds) {
    const int tid = opaque_tid(), lane = tid & 63, wid = tid >> 6;
    const float* lf = (const float*)(p.ws + WS_LF) + (size_t)head * MROWS; float* bk = (float*)(p.ws + WS_BK) + (size_t)head * MROWS;
    LAS float* wt = (LAS float*)lds;
    const int r0 = tid * 17;
    float v[17]; float s = 0.f;
#pragma unroll
    for (int i = 0; i < 17; ++i) { const int r = r0 + i; v[i] = r < MROWS ? lf[r] : 0.f; }
#pragma unroll
    for (int i = 0; i < 17; ++i) s += v[i];
    float inc = s;
#pragma unroll
    for (int o = 1; o < 64; o <<= 1) { const float t = __shfl_up(inc, o); if (lane >= o) inc += t; }
    if (lane == 63) wt[wid] = inc;
    __syncthreads();
    float base = 0.f;
    for (int w = 0; w < wid; ++w) base += wt[w];
    float run = base + inc - s;
#pragma unroll
    for (int i = 0; i < 17; ++i) { const int r = r0 + i; run += v[i]; if (r < MROWS) bk[r] = -run * LOG2E; }
    __syncthreads();
}

__device__ __forceinline__ float gelu_tanh(float x) {
    const float y = 0.7978845608028654f * (x + 0.044715f * x * x * x);
    return x * __builtin_amdgcn_rcpf(1.0f + __builtin_amdgcn_exp2f(-2.0f * LOG2E * y));
}
__device__ __forceinline__ void phase_conv(const Params& p, int layer) {
    const bf16_t* U = (const bf16_t*)(p.ws + WS_U); bf16_t* Gd = (bf16_t*)(p.ws + WS_G);
    const float* wc = p.in[I_WCONV] + (size_t)layer * 3 * DFF2; const float* bc = p.in[I_BCONV] + (size_t)layer * DFF2;
    const int gtid = blockIdx.x * NTHREADS + opaque_tid(), nthr = gridDim.x * NTHREADS;
    constexpr int NCV = DFF / 8, RCH = 16, NCH = MROWS / RCH;
    for (int task = gtid; task < NCV * NCH; task += nthr) {
        const int cv = task % NCV, ch = task / NCV, c = cv * 8, r0 = ch * RCH;
        float wg[3][8], wu[3][8], bg[8], bu[8];
#pragma unroll
        for (int j = 0; j < 3; ++j)
#pragma unroll
            for (int e = 0; e < 8; e += 4) { *(f32x4*)&wg[j][e] = *(const f32x4*)(wc + j * DFF2 + c + e); *(f32x4*)&wu[j][e] = *(const f32x4*)(wc + j * DFF2 + DFF + c + e); }
#pragma unroll
        for (int e = 0; e < 8; e += 4) { *(f32x4*)&bg[e] = *(const f32x4*)(bc + c + e); *(f32x4*)&bu[e] = *(const f32x4*)(bc + DFF + c + e); }
        float g2[8], g1[8], u2[8], u1[8];
        if (r0 >= 2) {
            unpack8(__builtin_nontemporal_load((const u32x4*)(U + (size_t)(r0 - 2) * DFF2 + c)), g2); unpack8(__builtin_nontemporal_load((const u32x4*)(U + (size_t)(r0 - 2) * DFF2 + DFF + c)), u2);
            unpack8(__builtin_nontemporal_load((const u32x4*)(U + (size_t)(r0 - 1) * DFF2 + c)), g1); unpack8(__builtin_nontemporal_load((const u32x4*)(U + (size_t)(r0 - 1) * DFF2 + DFF + c)), u1);
        } else {
#pragma unroll
            for (int e = 0; e < 8; ++e) { g2[e] = 0.f; g1[e] = 0.f; u2[e] = 0.f; u1[e] = 0.f; }
        }
#pragma unroll
        for (int rb = 0; rb < RCH; rb += 8) {
            u32x4 gr[8], ur[8];
#pragma unroll
            for (int k = 0; k < 8; ++k) { gr[k] = __builtin_nontemporal_load((const u32x4*)(U + (size_t)(r0 + rb + k) * DFF2 + c)); ur[k] = __builtin_nontemporal_load((const u32x4*)(U + (size_t)(r0 + rb + k) * DFF2 + DFF + c)); }
#pragma unroll
            for (int k = 0; k < 8; ++k) {
                float g0[8], u0[8]; unpack8(gr[k], g0); unpack8(ur[k], u0);
                float o[8];
#pragma unroll
                for (int e = 0; e < 8; ++e) {
                    const float gp = bg[e] + wg[0][e] * g2[e] + wg[1][e] * g1[e] + wg[2][e] * g0[e];
                    const float up = bu[e] + wu[0][e] * u2[e] + wu[1][e] * u1[e] + wu[2][e] * u0[e];
                    o[e] = gelu_tanh(gp) * up;
                    g2[e] = g1[e]; g1[e] = g0[e]; u2[e] = u1[e]; u1[e] = u0[e];
                }
                u32x4 w; w.x = cvt_pk_bf16(o[0], o[1]); w.y = cvt_pk_bf16(o[2], o[3]); w.z = cvt_pk_bf16(o[4], o[5]); w.w = cvt_pk_bf16(o[6], o[7]);
                *(u32x4*)(Gd + (size_t)(r0 + rb + k) * DFF + c) = w;
            }
        }
    }
}

constexpr int SHM_V = 64 * 128 * 2;
__device__ __forceinline__ int v_st(int k, int c) { const int kk = (k & ~0xC) | ((k & 4) << 1) | ((k & 8) >> 1); return ((kk >> 3) * 4 + (c >> 5)) * 512 + ((kk & 7) * 32 + (c & 31)) * 2; }
__device__ __forceinline__ int v_rd_base(int lane) { return ((lane & 3) << 3) | (((lane >> 2) & 3) << 6) | (((lane >> 4) & 1) << 5) | (((lane >> 5) & 1) << 8); }
constexpr int v_rd_off(int d0, int ks, int half) { return d0 * 512 + ks * 4096 + half * 2048; }
__device__ __forceinline__ int crow(int r, int hi) { return (r & 3) + 8 * (r >> 2) + 4 * hi; }
#define SBAR() __builtin_amdgcn_sched_barrier(0)

template <int VB>
__device__ __forceinline__ void pv_tile(f32x16* o, int vb0, bf16x8 pa0, bf16x8 pa1, bf16x8 pa2, bf16x8 pa3) {
#define TRRD(dst, off) asm volatile("ds_read_b64_tr_b16 %0, %1 offset:%2" : "=&v"(dst) : "v"(vb0), "i"(off) : "memory")
#define PV_D0(d0) do { s16x4 l0, l1, l2, l3, h0, h1, h2, h3; constexpr int b_ = VB * SHM_V + v_rd_off(d0, 0, 0); \
        TRRD(l0, b_); TRRD(h0, b_ + 2048); TRRD(l1, b_ + 4096); TRRD(h1, b_ + 6144); TRRD(l2, b_ + 8192); TRRD(h2, b_ + 10240); TRRD(l3, b_ + 12288); TRRD(h3, b_ + 14336); \
        asm volatile("s_waitcnt lgkmcnt(0)" ::: "memory"); SBAR(); \
        o[d0] = __builtin_amdgcn_mfma_f32_32x32x16_bf16(pa0, (bf16x8){l0[0], l0[1], l0[2], l0[3], h0[0], h0[1], h0[2], h0[3]}, o[d0], 0, 0, 0); \
        o[d0] = __builtin_amdgcn_mfma_f32_32x32x16_bf16(pa1, (bf16x8){l1[0], l1[1], l1[2], l1[3], h1[0], h1[1], h1[2], h1[3]}, o[d0], 0, 0, 0); \
        o[d0] = __builtin_amdgcn_mfma_f32_32x32x16_bf16(pa2, (bf16x8){l2[0], l2[1], l2[2], l2[3], h2[0], h2[1], h2[2], h2[3]}, o[d0], 0, 0, 0); \
        o[d0] = __builtin_amdgcn_mfma_f32_32x32x16_bf16(pa3, (bf16x8){l3[0], l3[1], l3[2], l3[3], h3[0], h3[1], h3[2], h3[3]}, o[d0], 0, 0, 0); } while (0)
    PV_D0(0); PV_D0(1); PV_D0(2); PV_D0(3);
#undef PV_D0
#undef TRRD
}

template <int TYPE>
__device__ __forceinline__ void attn_item(const Params& p, int layer, int head, int qb, int mode, LAS unsigned char* lds) {
    constexpr int DQK = TYPE == 0 ? 192 : 128, NQ = DQK / 16, SHM_K = 64 * DQK * 2;
    constexpr int OFF_K = 2 * SHM_V, OFF_B = OFF_K + 2 * SHM_K;
    const int tid = opaque_tid(), wid = __builtin_amdgcn_readfirstlane(tid >> 6), lane = tid & 63, r32 = lane & 31, hi = lane >> 5;
    const int P0 = qb * 256, qrow = P0 + wid * 32 + r32;
    const bf16_t* Qb; int ldq; const bf16_t* Kn; int ldk; const bf16_t* Vp; int ldv;
    if (TYPE == 0) { Qb = (const bf16_t*)(p.ws + WS_QM) + head * 192; ldq = 1536; Kn = (const bf16_t*)(p.ws + WS_KV) + head * 256; ldk = 2048; Vp = Kn + 128; ldv = 2048; }
    else { Qb = (const bf16_t*)(p.ws + WS_QF) + head * 128; ldq = 1024; Kn = (const bf16_t*)(p.ws + WS_KF) + head * 128; ldk = 1024; Vp = (const bf16_t*)(p.ws + WS_Z) + 3072 + head * 128; ldv = ZLD; }
    const bf16_t* Krp = (const bf16_t*)(p.ws + WS_KR);
    const float* bias = (const float*)(p.ws + WS_BK) + (size_t)head * MROWS;
#define KMAX(pos) (TYPE == 0 ? ((pos) | 63) : (pos))
    const int my_kmax = KMAX(qrow);
    const int w_first = KMAX(P0 + wid * 32), w_last = KMAX(P0 + wid * 32 + 31);
    int blk_kmax = KMAX(P0 + 255); if (blk_kmax > MROWS - 1) blk_kmax = MROWS - 1;
    const int NT = blk_kmax / 64 + 1;
    bf16x8 qr[NQ];
#pragma unroll
    for (int d0 = 0; d0 < NQ; ++d0) qr[d0] = *(const bf16x8*)(Qb + (size_t)qrow * ldq + d0 * 16 + hi * 8);
    LAS unsigned char* V_lds = lds; LAS unsigned char* K_lds = lds + OFF_K; LAS float* B_lds = (LAS float*)(lds + OFF_B);
    LAS float* wsl = (LAS float*)(lds + LDS_BYTES - 4096) + wid * 64;
    const int vb0 = (int)(unsigned)(uintptr_t)V_lds + v_rd_base(lane);
    unsigned offK[2], offV[2], offR;
#pragma unroll
    for (int j = 0; j < 2; ++j) {
        const int row = (j * 8 + wid) * 4 + (lane >> 4), ch = (lane & 15) ^ (row & 7);
        offK[j] = (unsigned)(row * ldk + ch * 8) * 2u;
        const int q = (j * 8 + wid) * 64 + lane, sub = q >> 5, kk = (sub >> 2) * 8 + ((q & 31) >> 2), c = (sub & 3) * 32 + (q & 3) * 8;
        const int k = (kk & ~0xC) | ((kk & 4) << 1) | ((kk & 8) >> 1);
        offV[j] = (unsigned)(k * ldv + c) * 2u;
    }
    { const int row = wid * 8 + (lane >> 3), ch = (lane & 7) ^ (row & 7); offR = (unsigned)(row * 64 + ch * 8) * 2u; }
#define ADMA(t, bf) do { const size_t k0_ = (size_t)(t) * 64; \
        const char* kp_ = (const char*)(Kn + k0_ * ldk); const char* vp_ = (const char*)(Vp + k0_ * ldv); \
        _Pragma("unroll") for (int j_ = 0; j_ < 2; ++j_) { \
            __builtin_amdgcn_global_load_lds((const unsigned*)(kp_ + offK[j_]), (LAS unsigned*)(K_lds + (bf) * SHM_K + (j_ * 8 + wid) * 1024), 16, 0, 0); \
            __builtin_amdgcn_global_load_lds((const unsigned*)(vp_ + offV[j_]), (LAS unsigned*)(V_lds + (bf) * SHM_V + (j_ * 8 + wid) * 1024), 16, 0, 0); } \
        if (TYPE == 0) __builtin_amdgcn_global_load_lds((const unsigned*)((const char*)(Krp + k0_ * 64) + offR), (LAS unsigned*)(K_lds + (bf) * SHM_K + 16384 + wid * 1024), 16, 0, 0); \
        else if (wid == 0) __builtin_amdgcn_global_load_lds((const unsigned*)(bias + k0_ + lane), (LAS unsigned*)(B_lds + (bf) * 64), 4, 0, 0); } while (0)
    float m_reg = -1e30f, l_reg = 0.f; f32x16 o[4];
#pragma unroll
    for (int d = 0; d < 4; ++d) o[d] = (f32x16){};
    constexpr int T0 = PADR / 64;
    int tbeg = T0; float Bb = 0.f;
    if (TYPE == 1) {
        const float* gq = p.in[I_GFQ] + layer * 128; const float* gk = p.in[I_GFK] + layer * 128;
        float gm = fmaxf(fabsf(gq[lane] * gk[lane]), fabsf(gq[lane + 64] * gk[lane + 64]));
#pragma unroll
        for (int o_ = 32; o_ >= 1; o_ >>= 1) gm = fmaxf(gm, __shfl_xor(gm, o_));
        Bb = gm * 11.313708498984761f * LOG2E * 1.02f;
    }
    int tend = NT;
    if (TYPE == 0 && mode != 0) { const int mid = (T0 + NT + 1) >> 1; if (mode == 1) tend = mid; else tbeg = mid; }
    const int ntiles = tend - tbeg, tfirst = TYPE == 1 ? tend - 1 : tbeg;
    LAS float* xm = (LAS float*)(lds + LDS_BYTES - 2048);
    ADMA(tfirst, tfirst & 1);
    asm volatile("s_waitcnt vmcnt(0)" ::: "memory");
    __syncthreads();
    int kb[4], kbr[4];
#pragma unroll
    for (int dd = 0; dd < 4; ++dd) { kb[dd] = r32 * 256 + ((((dd * 2 + hi) ^ (r32 & 7))) << 4); kbr[dd] = 16384 + r32 * 128 + ((((dd * 2 + hi) ^ (r32 & 7))) << 4); }
    for (int it2 = 0; it2 < ntiles; ++it2) {
        const int t = TYPE == 1 ? tfirst - it2 : tfirst + it2, tn = TYPE == 1 ? t - 1 : t + 1;
        const int bf = t & 1, kbase = t * 64;
        if (it2 + 1 < ntiles) { ADMA(tn, bf ^ 1); }
        if (kbase <= w_last) {
            f32x16 p0 = (f32x16){}, p1 = (f32x16){};
            const LAS unsigned char* kt = K_lds + bf * SHM_K;
#pragma unroll
            for (int d0 = 0; d0 < NQ; ++d0) {
                const LAS unsigned char* a = d0 < 8 ? kt + kb[d0 & 3] + (d0 >> 2) * 128 : kt + kbr[d0 & 3];
                const bf16x8 b0 = *(const LAS bf16x8*)a, b1 = *(const LAS bf16x8*)(a + (d0 < 8 ? 32 * 256 : 32 * 128));
                p0 = __builtin_amdgcn_mfma_f32_32x32x16_bf16(b0, qr[d0], p0, 0, 0, 0);
                p1 = __builtin_amdgcn_mfma_f32_32x32x16_bf16(b1, qr[d0], p1, 0, 0, 0);
                if ((d0 & 3) == 3) SBAR();
            }
            if (TYPE == 1) {
                const LAS float* bb = B_lds + bf * 64 + 4 * hi;
#pragma unroll
                for (int q4 = 0; q4 < 4; ++q4) {
                    const f32x4 b0 = *(const LAS f32x4*)(bb + 8 * q4), b1 = *(const LAS f32x4*)(bb + 32 + 8 * q4);
#pragma unroll
                    for (int j = 0; j < 4; ++j) { p0[q4 * 4 + j] += b0[j]; p1[q4 * 4 + j] += b1[j]; }
                }
            }
            if (TYPE == 1 && kbase + 63 > w_first) {
                const int lim = my_kmax - kbase - 4 * hi; const float NEGI = -__builtin_inff();
#pragma unroll
                for (int r = 0; r < 16; ++r) { const int c = (r & 3) + 8 * (r >> 2); if (c > lim) p0[r] = NEGI; if (c + 32 > lim) p1[r] = NEGI; }
            }
            if (t == T0) {
                const int lo = (PADR & 63) - 4 * hi; const float NEGI = -__builtin_inff();
#pragma unroll
                for (int r = 0; r < 16; ++r) { const int c = (r & 3) + 8 * (r >> 2); if (c < lo) p0[r] = NEGI; if (c + 32 < lo) p1[r] = NEGI; }
            }
            float pmax = p0[0];
#pragma unroll
            for (int r = 1; r < 16; ++r) pmax = fmaxf(pmax, p0[r]);
#pragma unroll
            for (int r = 0; r < 16; ++r) pmax = fmaxf(pmax, p1[r]);
            { auto rr = __builtin_amdgcn_permlane32_swap(__float_as_uint(pmax), __float_as_uint(pmax), false, false);
              pmax = fmaxf(__uint_as_float(rr[0]), __uint_as_float(rr[1])); }
            float mn, alpha;
            if (__all((pmax - m_reg) <= (TYPE == 1 ? 2.0f : 11.5f))) { mn = m_reg; alpha = 1.f; }
            else { mn = fmaxf(m_reg, pmax); alpha = __builtin_amdgcn_exp2f(m_reg - mn); m_reg = mn; }
            float ps = 0.f;
#pragma unroll
            for (int r = 0; r < 16; ++r) { p0[r] = __builtin_amdgcn_exp2f(p0[r] - mn); p1[r] = __builtin_amdgcn_exp2f(p1[r] - mn); ps += p0[r] + p1[r]; }
            { auto rr = __builtin_amdgcn_permlane32_swap(__float_as_uint(ps), __float_as_uint(ps), false, false);
              ps = __uint_as_float(rr[0]) + __uint_as_float(rr[1]); }
            l_reg = l_reg * alpha + ps;
            bf16x8 pa0, pa1, pa2, pa3;
#define PK4(P, B_, OUT) do { unsigned a0 = cvt_pk_bf16(P[B_ + 0], P[B_ + 1]), a1 = cvt_pk_bf16(P[B_ + 2], P[B_ + 3]); \
        unsigned b0 = cvt_pk_bf16(P[B_ + 4], P[B_ + 5]), b1 = cvt_pk_bf16(P[B_ + 6], P[B_ + 7]); \
        auto r0 = __builtin_amdgcn_permlane32_swap(a0, b0, false, false); auto r1 = __builtin_amdgcn_permlane32_swap(a1, b1, false, false); \
        u32x4 w = {r0[0], r1[0], r0[1], r1[1]}; OUT = *reinterpret_cast<bf16x8*>(&w); } while (0)
            PK4(p0, 0, pa0); PK4(p0, 8, pa1); PK4(p1, 0, pa2); PK4(p1, 8, pa3);
#undef PK4
            if (__any(alpha < 1.f)) {
                if (hi == 0) wsl[r32] = alpha;
                asm volatile("s_waitcnt lgkmcnt(0)" ::: "memory");
#pragma unroll
                for (int r = 0; r < 16; ++r) { const float al = wsl[crow(r, hi)];
#pragma unroll
                    for (int d = 0; d < 4; ++d) o[d][r] *= al; }
            }
            if (bf == 0) pv_tile<0>(o, vb0, pa0, pa1, pa2, pa3); else pv_tile<1>(o, vb0, pa0, pa1, pa2, pa3);
        }
        if (TYPE == 1) {
            float mm = m_reg;
#pragma unroll
            for (int o_ = 16; o_ >= 1; o_ >>= 1) mm = fminf(mm, __shfl_xor(mm, o_));
            if (lane == 0) xm[(it2 & 1) * 8 + wid] = mm;
        }
        asm volatile("s_waitcnt vmcnt(0)" ::: "memory");
        __syncthreads();
        if (TYPE == 1 && it2 + 1 < ntiles) {
            const LAS float* xr = xm + (it2 & 1) * 8;
            const float mmin = fminf(fminf(fminf(xr[0], xr[1]), fminf(xr[2], xr[3])), fminf(fminf(xr[4], xr[5]), fminf(xr[6], xr[7])));
            const float bend = B_lds[(bf ^ 1) * 64 + 63];
            if (__builtin_amdgcn_readfirstlane(Bb + bend + 32.0f < mmin)) break;
        }
    }
    if (TYPE == 0 && mode != 0) {
        const int pi = (head * 25 + (qb - 8)) * 2 + (mode - 1);
        float* Op = (float*)(p.ws + WS_U) + (size_t)pi * (256 * 128) + (size_t)(wid * 32) * 128;
        float* ML = (float*)(p.ws + WS_U) + (size_t)400 * (256 * 128) + (size_t)pi * 512 + (wid * 32 + r32) * 2;
#pragma unroll
        for (int r = 0; r < 16; ++r)
#pragma unroll
            for (int d0 = 0; d0 < 4; ++d0) Op[crow(r, hi) * 128 + d0 * 32 + r32] = o[d0][r];
        if (hi == 0) { ML[0] = m_reg; ML[1] = l_reg; }
        __syncthreads();
        return;
    }
    if (hi == 0) wsl[32 + r32] = l_reg;
    asm volatile("s_waitcnt lgkmcnt(0)" ::: "memory");
    {
        LAS unsigned char* ot = lds + wid * 8704;
#pragma unroll
        for (int r = 0; r < 16; ++r) {
            const float rl = __builtin_amdgcn_rcpf(fmaxf(wsl[32 + crow(r, hi)], 1e-30f));
#pragma unroll
            for (int d0 = 0; d0 < 4; ++d0) {
                const unsigned w = cvt_pk_bf16(o[d0][r] * rl, 0.f);
                *(LAS bf16_t*)(ot + crow(r, hi) * 272 + (d0 * 32 + r32) * 2) = (bf16_t)(w & 0xffffu);
            }
        }
        asm volatile("s_waitcnt lgkmcnt(0)" ::: "memory");
        bf16_t* Cat = (bf16_t*)(p.ws + WS_CAT) + (TYPE == 0 ? 0 : 1024) + head * 128;
        const bf16_t* gate = (const bf16_t*)(p.ws + WS_Z) + 4096 + head * 128;
#pragma unroll 2
        for (int i = 0; i < 8; ++i) {
            const int id = i * 64 + lane, rr = id >> 4, ch = id & 15;
            const int orow = P0 + wid * 32 + rr;
            u32x4 w = *(const LAS u32x4*)(ot + rr * 272 + ch * 16);
            if (TYPE == 1) {
                const u32x4 gw = __builtin_nontemporal_load((const u32x4*)(gate + (size_t)orow * ZLD + ch * 8));
                float v[8], gv[8]; unpack8(w, v); unpack8(gw, gv);
#pragma unroll
                for (int e = 0; e < 8; ++e) v[e] *= __builtin_amdgcn_rcpf(1.0f + __builtin_amdgcn_exp2f(-LOG2E * gv[e]));
                w.x = cvt_pk_bf16(v[0], v[1]); w.y = cvt_pk_bf16(v[2], v[3]); w.z = cvt_pk_bf16(v[4], v[5]); w.w = cvt_pk_bf16(v[6], v[7]);
            }
            *(u32x4*)(Cat + (size_t)orow * DM + ch * 8) = w;
        }
    }
    __syncthreads();
#undef KMAX
#undef ADMA
}

__constant__ unsigned char MLA_ORDER[58] = {96, 160, 95, 159, 94, 158, 93, 157, 92, 156, 91, 155, 90, 154, 89, 153, 88, 152, 87, 151, 86, 150, 85, 149, 84, 148, 83, 147, 82, 146, 81, 145, 80, 144, 79, 143, 7, 78, 142, 77, 141, 6, 76, 140, 75, 139, 5, 74, 138, 73, 137, 4, 72, 136, 3, 2, 1, 0};
__device__ __forceinline__ void phase_attn_combine(const Params& p) {
    const int gtid = blockIdx.x * NTHREADS + opaque_tid(), nthr = gridDim.x * NTHREADS;
    const float* Ob = (const float*)(p.ws + WS_U); const float* MLb = Ob + (size_t)400 * (256 * 128);
    bf16_t* Cat = (bf16_t*)(p.ws + WS_CAT);
    for (int task = gtid; task < 200 * 4096; task += nthr) {
        const int item = task >> 12, rc = task & 4095, row = rc >> 4, ch = rc & 15, head = item / 25, qb = 8 + item % 25;
        const float* O0 = Ob + (size_t)(item * 2) * (256 * 128) + row * 128 + ch * 8; const float* O1 = O0 + 256 * 128;
        const float m0 = MLb[(item * 2) * 512 + row * 2], l0 = MLb[(item * 2) * 512 + row * 2 + 1], m1 = MLb[(item * 2 + 1) * 512 + row * 2], l1 = MLb[(item * 2 + 1) * 512 + row * 2 + 1];
        const float m = fmaxf(m0, m1), w0 = __builtin_amdgcn_exp2f(m0 - m), w1 = __builtin_amdgcn_exp2f(m1 - m);
        const float inv = __builtin_amdgcn_rcpf(fmaxf(l0 * w0 + l1 * w1, 1e-30f));
        const f32x4 a0 = __builtin_nontemporal_load((const f32x4*)O0), a1 = __builtin_nontemporal_load((const f32x4*)(O0 + 4)), b0 = __builtin_nontemporal_load((const f32x4*)O1), b1 = __builtin_nontemporal_load((const f32x4*)(O1 + 4));
        const f32x4 x = (a0 * w0 + b0 * w1) * inv, y = (a1 * w0 + b1 * w1) * inv;
        u32x4 w; w.x = cvt_pk_bf16(x[0], x[1]); w.y = cvt_pk_bf16(x[2], x[3]); w.z = cvt_pk_bf16(y[0], y[1]); w.w = cvt_pk_bf16(y[2], y[3]);
        *(u32x4*)(Cat + (size_t)(qb * 256 + row) * DM + head * 128 + ch * 8) = w;
    }
}
__device__ __forceinline__ void phase_attn(const Params& p, int layer, LAS unsigned char* lds) {
    int* ctr = (int*)(p.ws + WS_CTR) + layer;
    LAS int* sitem = (LAS int*)(lds + LDS_BYTES - 16);
    for (;;) {
        if (opaque_tid() == 0) *sitem = atomicAdd(ctr, 1);
        __syncthreads();
        const int it = *sitem;
        __syncthreads();
        if (it >= 464 + 264) break;
        if (it < 264) attn_item<1>(p, layer, it & 7, 32 - (it >> 3), 0, lds);
        else { const int e = MLA_ORDER[(it - 264) >> 3]; attn_item<0>(p, layer, it & 7, e & 63, e >> 6, lds); }
    }
}

__device__ __forceinline__ void convert_gap(const Params& p, int layer, int nwg, int base, int per, LAS unsigned char* lds) {
    if (layer + 1 >= NLAYER) return;
    const int G = gridDim.x, c = blockIdx.x, rem = nwg % G;
    const int limit = base == GAP_PRE ? GAP_BASE6 : CT_LAYER;
    if (rem == 0) { __syncthreads(); convert_jobs<false>(p, (layer + 1) * CT_LAYER + base + c, (layer + 1) * CT_LAYER + limit, G, lds); return; }
    if (c < rem) return;
    const int slot = c - rem, nslots = G - rem;
    int j0 = base + slot * per, j1 = j0 + per;
    if (slot == nslots - 1 || j1 > limit) j1 = limit;
    if (j0 > limit) j0 = limit;
    __syncthreads();
    convert_jobs<false>(p, (layer + 1) * CT_LAYER + j0, (layer + 1) * CT_LAYER + j1, 1, lds);
}

#ifndef PHMASK0
#define PHMASK0 1
#endif
__device__ __forceinline__ void run_phase(const Params& pin, int ph, LAS unsigned char* lds, const XcdBarrier& xb) {
    Params p; p.ws = pin.ws; p.out = pin.out; p.ph_lo = pin.ph_lo; p.ph_hi = pin.ph_hi; asm volatile("" : "+s"(p.ws));
    {
        const float* const* tab = (const float* const*)(p.ws + WS_PTRS);
#pragma unroll
        for (int i = 0; i < 19; ++i) { const unsigned long long v = (unsigned long long)tab[i];
            const unsigned lo = __builtin_amdgcn_readfirstlane((unsigned)v), hi2 = __builtin_amdgcn_readfirstlane((unsigned)(v >> 32));
            p.in[i] = (const float*)(((unsigned long long)hi2 << 32) | lo); }
    }
    const int layer = (ph - 1) / 9, s = (ph - 1) % 9;
    unsigned char* wl = p.ws + WS_W + (size_t)layer * WL_SIZE;
    const float* cosT = (const float*)(p.ws + WS_COS); const float* sinT = (const float*)(p.ws + WS_SIN);
    float* ssqc = (float*)(p.ws + WS_SSQC);
    pg8::StaticOrder S;
#ifndef PHMASK
#define PHMASK 0x3ff
#endif
    if (!((PHMASK >> s) & 1)) return;
    switch (s) {
    case 0: {
        pg8::Gemm g{(const char*)(p.ws + WS_ABF), (const char*)(wl + WL_IN), DM, DM, 33, 21, 1 << 30, 0};
        S.init(33, 21, gridDim.x, blockIdx.x, 32);
        EpiIn E{(bf16_t*)(p.ws + WS_Z), ssqc, (bf16_t*)(p.ws + WS_KR), (float*)(p.ws + WS_LF), cosT, sinT, p.in[I_BF] + layer * 8};
        pg8::gemm_phase<EpiIn, pg8::StaticOrder>(lds, g, S, E);
        convert_gap(p, layer, 33 * 21, GAP_PRE, GAP_J1, lds);
    } break;
    case 1: {
        pg8::Gemm g{(const char*)(p.ws + WS_Z), (const char*)(wl + WL_QUP), ZLD, 512, 33, 14, 6, 1024};
        S.init(33, 14, gridDim.x, blockIdx.x, 8);
        EpiUp E{(bf16_t*)(p.ws + WS_QM), (bf16_t*)(p.ws + WS_KV), ssqc, cosT, sinT};
        pg8::gemm_phase<EpiUp, pg8::StaticOrder>(lds, g, S, E);
        __syncthreads();
        if ((int)blockIdx.x >= (int)gridDim.x - 8) phase_scan(p, (int)gridDim.x - 1 - (int)blockIdx.x, lds);
        phase_foxnorm(p, layer);
    } break;
    case 2: phase_attn(p, layer, lds); xcd_barrier(xb); phase_attn_combine(p); break;
    case 3: {
        pg8::Gemm g{(const char*)(p.ws + WS_CAT), (const char*)(wl + WL_OUT), DM, DM, 33, 8, 1 << 30, 0};
        pg8::SplitOrder SS; SS.init(32, 8, gridDim.x, blockIdx.x, 32, 16, 2);
        EpiF32 E{(bf16_t*)(p.ws + WS_MIX), (float*)(p.ws + WS_PART)};
        pg8::gemm_phase<EpiF32, pg8::SplitOrder>(lds, g, SS, E);
    } break;
    case 4: phase_resid(p, p.in[I_LNMIXPOST] + layer * DM, layer == 0, false, 16); break;
    case 5: {
        pg8::Gemm g{(const char*)(p.ws + WS_ABF), (const char*)(wl + WL_UP), DM, DM, 33, 44, 1 << 30, 0};
        S.init(33, 44, gridDim.x, blockIdx.x, 32);
        EpiU E{(bf16_t*)(p.ws + WS_U)};
        pg8::gemm_phase<EpiU, pg8::StaticOrder>(lds, g, S, E);
        convert_gap(p, layer, 33 * 44, GAP_BASE6, GAP_J6, lds);
    } break;
    case 6: phase_conv(p, layer); break;
    case 7: {
        pg8::Gemm g{(const char*)(p.ws + WS_G), (const char*)(wl + WL_DOWN), DFF, DFF, 33, 8, 1 << 30, 0};
        pg8::SplitOrder SS; SS.init(32, 8, gridDim.x, blockIdx.x, 88, 22, 4);
        EpiF32 E{(bf16_t*)(p.ws + WS_MIX), (float*)(p.ws + WS_PART)};
        pg8::gemm_phase<EpiF32, pg8::SplitOrder>(lds, g, SS, E);
    } break;
    case 8: phase_resid(p, p.in[I_LNFFNPOST] + layer * DM, false, layer == NLAYER - 1, 22); break;
    }
}

constexpr int NPHASE = 1 + 9 * NLAYER;

__global__ void __launch_bounds__(NTHREADS, 2) fwd_megakernel(Params p) {
    extern __shared__ __attribute__((aligned(16))) unsigned char smem[];
    LAS unsigned char* lds = (LAS unsigned char*)smem;
    cg::grid_group grid = cg::this_grid();
    volatile LAS unsigned* xst = (volatile LAS unsigned*)(lds + LDS_BYTES);
    if (threadIdx.x < 4) xst[threadIdx.x] = 0u;
    __syncthreads();
    const XcdBarrier xbar = xcd_barrier_post((unsigned*)(p.ws + WS_BAR), xst);
    int ph = p.ph_lo;
    if (ph == 0) {
        if (PHMASK0) phase_prep(p, lds);
        if (blockIdx.x == 0 && opaque_tid() == 0) {
#pragma unroll
            for (int i = 0; i < 19; ++i) ((const float**)(p.ws + WS_PTRS))[i] = p.in[i];
        }
        ++ph;
        if (p.ph_hi < 0) grid.sync();
        if (ph < p.ph_hi) xcd_barrier(xbar);
    }
    for (; ph < p.ph_hi; ++ph) {
        run_phase(p, ph, lds, xbar);
        if (ph + 1 < p.ph_hi) xcd_barrier(xbar);
    }
}

extern "C" void kernel_launch(void* const* d_in, const int* in_sizes, int n_in, void* d_out, int out_size, void* d_ws, size_t ws_size, hipStream_t stream) {
    static int grid = 0;
    if (grid == 0) {
        if (n_in != 19 || ws_size < WS_END) { fprintf(stderr, "kernel_launch: need 19 inputs and %zu bytes of workspace (got %d, %zu)\n", (size_t)WS_END, n_in, ws_size); grid = -1; return; }
        int dev = 0, cus = 0, per_cu = 0;
        hipGetDevice(&dev);
        hipDeviceGetAttribute(&cus, hipDeviceAttributeMultiprocessorCount, dev);
        if (hipFuncSetAttribute((const void*)fwd_megakernel, hipFuncAttributeMaxDynamicSharedMemorySize, LDS_TOTAL) != hipSuccess) { fprintf(stderr, "kernel_launch: hipFuncSetAttribute failed\n"); grid = -1; return; }
        hipOccupancyMaxActiveBlocksPerMultiprocessor(&per_cu, (const void*)fwd_megakernel, NTHREADS, LDS_TOTAL);
        if (per_cu < 1) { fprintf(stderr, "kernel_launch: occupancy query says %d blocks/CU\n", per_cu); per_cu = 1; }
        grid = cus * 1;
        (void)hipGetLastError();
    }
    if (grid < 0) return;
    Params p{};
    for (int i = 0; i < 19; ++i) p.in[i] = (const float*)d_in[i];
    p.out = (float*)d_out; p.ws = (unsigned char*)d_ws;
    if (hipMemsetAsync((char*)d_ws + WS_BAR, 0, 16384, stream) != hipSuccess) { fprintf(stderr, "kernel_launch: memset of the barrier words failed\n"); return; }
#if SINGLE_LAUNCH
    p.ph_lo = 0; p.ph_hi = NPHASE;
    void* args[] = {&p};
    hipError_t e = hipLaunchCooperativeKernel((const void*)fwd_megakernel, dim3(grid), dim3(NTHREADS), args, LDS_TOTAL, stream);
    if (e != hipSuccess) fprintf(stderr, "cooperative launch failed: %s (grid %d)\n", hipGetErrorString(e), grid);
#else
    for (int ph = 0; ph < NPHASE; ++ph) {
        p.ph_lo = ph; p.ph_hi = ph + 1;
        hipLaunchKernelGGL(fwd_megakernel, dim3(grid), dim3(NTHREADS), LDS_TOTAL, stream, p);
    }
#endif
}
```
